# Optimizing an MI355X kernel written in HIP

```python
import math
import jax, jax.numpy as jnp
from jax import lax
import numpy as np


D_MODEL = 2048
BATCH = 2
SEQ = 4096
DEPTH = 1

MIX_WIDTH = D_MODEL
ATTN_WIDTH = MIX_WIDTH // 2
POOL_WIDTH = MIX_WIDTH - ATTN_WIDTH
HEAD_DIM = 64
N_ATTN_HEADS = ATTN_WIDTH // (2 * HEAD_DIM)
ROT_DIM = HEAD_DIM // 4
ROPE_THETA = 500000.0
POOL_WINDOWS = (2, 4, 8, 16)
N_POOL_GROUPS = len(POOL_WINDOWS)
POOL_GROUP = POOL_WIDTH // N_POOL_GROUPS
IN_WIDTH = 4 * ATTN_WIDTH + 2 * POOL_WIDTH
Q_BLOCK = 128
EPS = 1e-6

kernel_name = 'hybrid_diffattn_pool_block'


def lambda_init(layer_idx):
    return 0.8 - 0.6 * math.exp(-0.3 * (layer_idx - 1))


def rms_norm(x, w):
    xf = x.astype(jnp.float32)
    y = xf * lax.rsqrt(jnp.mean(xf * xf, axis=-1, keepdims=True) + EPS)
    return (y * w.astype(jnp.float32)).astype(x.dtype)


def rope_partial(t, cos, sin):
    half = ROT_DIM // 2
    tf = t.astype(jnp.float32)
    t1 = tf[..., :half]
    t2 = tf[..., half:ROT_DIM]
    out = jnp.concatenate([t1 * cos - t2 * sin, t2 * cos + t1 * sin, tf[..., ROT_DIM:]], axis=-1)
    return out.astype(t.dtype)


def diff_attention(q, k, v, q_norm_w, k_norm_w, lq1, lk1, lq2, lk2, subln_w, lam_init):
    B, S, _ = q.shape
    H, d = N_ATTN_HEADS, HEAD_DIM
    q = rms_norm(q.reshape(B, S, H, 2, d), q_norm_w)
    k = rms_norm(k.reshape(B, S, H, 2, d), k_norm_w)
    pos = jnp.arange(S, dtype=jnp.float32)
    inv_freq = ROPE_THETA ** (-jnp.arange(0, ROT_DIM, 2, dtype=jnp.float32) / ROT_DIM)
    ang = pos[:, None] * inv_freq[None, :]
    cos = jnp.cos(ang)[None, :, None, None, :]
    sin = jnp.sin(ang)[None, :, None, None, :]
    q = rope_partial(q, cos, sin)
    k = rope_partial(k, cos, sin)
    vh = v.reshape(B, S, H, 2 * d).transpose(0, 2, 1, 3)
    kt = k.transpose(0, 2, 3, 1, 4)
    nb = S // Q_BLOCK
    qb = q.reshape(B, nb, Q_BLOCK, H, 2, d).transpose(1, 0, 3, 4, 2, 5)
    f32 = jnp.float32
    lam = (jnp.exp(jnp.sum(lq1.astype(f32) * lk1.astype(f32)))
           - jnp.exp(jnp.sum(lq2.astype(f32) * lk2.astype(f32))) + lam_init)
    scale = 1.0 / math.sqrt(d)

    def block(qblk):
        s = jnp.einsum('bhcqd,bhckd->bhcqk', qblk, kt).astype(f32) * scale
        p = jax.nn.softmax(s, axis=-1)
        a = p[:, :, 0] - lam * p[:, :, 1]
        return jnp.einsum('bhqk,bhke->bhqe', a.astype(vh.dtype), vh)

    o = lax.map(block, qb)
    o = o.transpose(1, 0, 3, 2, 4).reshape(B, S, H, 2 * d)
    o = rms_norm(o, subln_w) * (1.0 - lam_init)
    return o.reshape(B, S, ATTN_WIDTH)


def centred_mean(u, w):
    B, S, C = u.shape
    lo = w // 2
    hi = w - 1 - lo
    up = jnp.pad(u.astype(jnp.float32), ((0, 0), (lo + 1, hi), (0, 0)))
    c = lax.cumsum(up, axis=1)
    total = c[:, w:w + S] - c[:, :S]
    pos = jnp.arange(S)
    cnt = (jnp.minimum(pos + hi, S - 1) - jnp.maximum(pos - lo, 0) + 1).astype(jnp.float32)
    return total / cnt[None, :, None]


def multiscale_pool(u, w_pool, pool_scale):
    B, S, _ = u.shape
    ug = u.reshape(B, S, N_POOL_GROUPS, POOL_GROUP)
    diffs = [centred_mean(ug[:, :, g], w) - ug[:, :, g].astype(jnp.float32)
             for g, w in enumerate(POOL_WINDOWS)]
    dg = jnp.stack(diffs, axis=2).astype(u.dtype)
    y = jnp.einsum('bsgc,gcd->bsgd', dg, w_pool).reshape(B, S, POOL_WIDTH)
    return y * pool_scale


def setup_inputs(seed: int = 0) -> dict:
    key = jax.random.key(seed)
    ks = jax.random.split(key, 14)
    nrm = jax.random.normal
    f32 = jnp.float32
    x = nrm(ks[0], (BATCH, SEQ, D_MODEL), f32)
    norm_w = 1.0 + 0.02 * nrm(ks[1], (DEPTH, D_MODEL), f32)
    w_in = nrm(ks[2], (DEPTH, D_MODEL, IN_WIDTH), f32) * D_MODEL ** -0.5
    q_norm_w = 1.0 + 0.02 * nrm(ks[3], (DEPTH, HEAD_DIM), f32)
    k_norm_w = 1.0 + 0.02 * nrm(ks[4], (DEPTH, HEAD_DIM), f32)
    lambda_q1 = 0.1 * nrm(ks[5], (DEPTH, HEAD_DIM), f32)
    lambda_k1 = 0.1 * nrm(ks[6], (DEPTH, HEAD_DIM), f32)
    lambda_q2 = 0.1 * nrm(ks[7], (DEPTH, HEAD_DIM), f32)
    lambda_k2 = 0.1 * nrm(ks[8], (DEPTH, HEAD_DIM), f32)
    subln_w = 1.0 + 0.02 * nrm(ks[9], (DEPTH, 2 * HEAD_DIM), f32)
    w_pool = nrm(ks[10], (DEPTH, N_POOL_GROUPS, POOL_GROUP, POOL_GROUP), f32) * POOL_GROUP ** -0.5
    pool_scale = 1.0 + 0.02 * nrm(ks[11], (DEPTH, POOL_WIDTH), f32)
    w_out = nrm(ks[12], (DEPTH, MIX_WIDTH, D_MODEL), f32) * MIX_WIDTH ** -0.5
    return {'x': x, 'norm_w': norm_w, 'w_in': w_in, 'q_norm_w': q_norm_w, 'k_norm_w': k_norm_w,
            'lambda_q1': lambda_q1, 'lambda_k1': lambda_k1, 'lambda_q2': lambda_q2, 'lambda_k2': lambda_k2,
            'subln_w': subln_w, 'w_pool': w_pool, 'pool_scale': pool_scale, 'w_out': w_out}


def reference(x, norm_w, w_in, q_norm_w, k_norm_w, lambda_q1, lambda_k1, lambda_q2, lambda_k2,
              subln_w, w_pool, pool_scale, w_out):
    A, P = ATTN_WIDTH, POOL_WIDTH
    for l in range(DEPTH):
        h = rms_norm(x, norm_w[l])
        proj = h @ w_in[l]
        q, k, v, g_a, u_p, g_p = jnp.split(proj, [A, 2 * A, 3 * A, 4 * A, 4 * A + P], axis=-1)
        attn = diff_attention(q, k, v, q_norm_w[l], k_norm_w[l], lambda_q1[l], lambda_k1[l],
                              lambda_q2[l], lambda_k2[l], subln_w[l], lambda_init(l + 1))
        pool = multiscale_pool(u_p, w_pool[l], pool_scale[l])
        mixed = jnp.concatenate([attn * jax.nn.silu(g_a), pool * jax.nn.silu(g_p)], axis=-1)
        x = x + mixed @ w_out[l]
    return x
```

```cpp
#include <hip/hip_runtime.h>
#include <hip/hip_cooperative_groups.h>
#include <hip/hip_bf16.h>
#include <cstdio>
#include <cstdint>
#include <cmath>
namespace cg = cooperative_groups;

#ifndef PROBE_EXTRA_PHASE
#define PROBE_EXTRA_PHASE -1
#endif
#ifndef MK_N_LAUNCHES
#define MK_N_LAUNCHES 1
#endif

namespace pg8 {
#define PG8_LAS __attribute__((address_space(3)))
typedef unsigned short bf16_t;
typedef short bf16x8 __attribute__((ext_vector_type(8)));
typedef float f32x4 __attribute__((ext_vector_type(4)));
typedef unsigned u32x4 __attribute__((ext_vector_type(4)));
constexpr int BM = 256, BK = 64, HALF = 128, HTB = HALF * BK * 2  , STAGE_BYTES = 8 * HTB, NXCD = 8, WGM = 8;

__host__ __device__ __forceinline__ int lds_byte(int r, int c) { const int st = (r >> 4) * 2 + (c >> 5), rr = r & 15, cc = c & 31, ob = rr * 64 + cc * 2; return st * 1024 + (ob ^ (((ob >> 9) & 1) << 5)); }
__host__ __device__ __forceinline__ void stage_rc(int b, int& R, int& C) { const int st = b / 1024, sb = b % 1024, swz = sb ^ (((sb >> 9) & 1) << 5); R = (st >> 1) * 16 + swz / 64; C = (st & 1) * 32 + (swz % 64) / 2; }
__host__ __device__ __forceinline__ int perm32(int rho) { const int n = rho >> 4, i = rho & 15; return 8 * (i >> 2) + 4 * n + (i & 3); }

struct Unit { int pm, pn; };
struct Gemm { const bf16_t* A; const bf16_t* Bt; int M, N, K; };

struct StaticOrder {
    int nM, nN, nwg, G, c;
    __host__ __device__ void init(int M, int N, int G_, int c_) { nM = M / BM; nN = N / BM; nwg = nM * nN; G = G_; c = c_; }
    __host__ __device__ bool next(int i, Unit& u) const {
        const long L = (long)i * G + c; if (L >= nwg) return false;
        int wgid = (int)L; { const int q = nwg / NXCD, r = nwg % NXCD, xcd = wgid % NXCD, off = wgid / NXCD; wgid = (xcd < r ? xcd * (q + 1) : r * (q + 1) + (xcd - r) * q) + off; }
        const int nig = WGM * nN, gid = wgid / nig, fm = gid * WGM, gsz = (nM - fm) < WGM ? (nM - fm) : WGM;
        u.pm = fm + ((wgid % nig) % gsz); u.pn = (wgid % nig) / gsz; return true;
    }
    __device__ __forceinline__ void a_ready(const Unit&) const {}
    __device__ __forceinline__ void done(const Unit&) const {}
};

__device__ __forceinline__ unsigned cvt_pk_bf16(float lo, float hi) { unsigned r; asm volatile("v_cvt_pk_bf16_f32 %0, %1, %2" : "=v"(r) : "v"(lo), "v"(hi)); return r; }
template <class Epi, class Sched, bool ALIGN_EPI = false, bool SP2 = false>
__device__ __forceinline__ void gemm_phase(PG8_LAS unsigned char* lds, const Gemm g, const Sched& S, const Epi& E) {
    int tid = threadIdx.x; asm volatile("" : "+v"(tid));
    const int wid = __builtin_amdgcn_readfirstlane(tid >> 6), lane = tid & 63, wr = wid >> 2, wc = wid & 3, fr = lane & 15, fq = lane >> 4;
    const int K = g.K, nt = K / BK;
    unsigned voffA[2], voffB[2];
#pragma unroll
    for (int i = 0; i < 2; ++i) { int R, C; stage_rc(tid * 16 + i * 8192, R, C); const int Rb = Epi::PERM ? ((R & ~31) + perm32(R & 31)) : R;
        voffA[i] = (unsigned)(R * K + C) * 2u; voffB[i] = (unsigned)(Rb * K + C) * 2u; }
    const size_t kstep = (size_t)(BK * 2);
    const size_t hstep = (size_t)HALF * K * 2;
    const size_t tstep = 2 * hstep;
    const unsigned ldsw = (unsigned)wid * 1024u;
    const int aoff = lds_byte(wr * 64 + fr, fq * 8), boff = lds_byte(wc * 32 + fr, fq * 8);
#define PG8_SA(b, h) (((b) * 2 + (h)) * HTB)
#define PG8_SB(b, h) ((4 + (b) * 2 + (h)) * HTB)
#define PG8_STAGE(bufoff, gbase, voff) do { _Pragma("unroll") for (int _i = 0; _i < 2; ++_i) \
        __builtin_amdgcn_global_load_lds((const unsigned*)((const char*)(gbase) + (voff)[_i]), (PG8_LAS unsigned*)(lds + (bufoff) + ldsw + _i * 8192), 16, 0, 0); } while (0)
#define PG8_LDA(dst, b, h) do { _Pragma("unroll") for (int m = 0; m < 4; ++m) _Pragma("unroll") for (int k = 0; k < 2; ++k) dst[m][k] = *(const PG8_LAS bf16x8*)(lds + PG8_SA(b, h) + aoff + m * 2048 + k * 1024); } while (0)
#define PG8_LDB(dst, b, h) do { _Pragma("unroll") for (int n = 0; n < 2; ++n) _Pragma("unroll") for (int k = 0; k < 2; ++k) dst[n][k] = *(const PG8_LAS bf16x8*)(lds + PG8_SB(b, h) + boff + n * 2048 + k * 1024); } while (0)
#define PG8_MMA(ai, bj, At, Bt) do { __builtin_amdgcn_s_setprio(1); _Pragma("unroll") for (int m = 0; m < 4; ++m) _Pragma("unroll") for (int n = 0; n < 2; ++n) _Pragma("unroll") for (int k = 0; k < 2; ++k) \
        acc[ai][bj][m][n] = __builtin_amdgcn_mfma_f32_16x16x32_bf16(Bt[n][k], At[m][k], acc[ai][bj][m][n], 0, 0, 0); __builtin_amdgcn_s_setprio(0); } while (0)
#define PG8_WAIT_V(n) asm volatile("s_waitcnt vmcnt(" #n ")" ::: "memory")
#define PG8_WAIT_L(n) asm volatile("s_waitcnt lgkmcnt(" #n ")" ::: "memory")
#define PG8_BAR __builtin_amdgcn_s_barrier()
#define PG8_SCHED __builtin_amdgcn_sched_barrier(0)
    Unit cur, nxt; int ui = 0;
    if (!S.next(0, cur)) return;
    f32x4 acc[2][2][4][2];
    if constexpr (Epi::INIT) E.init(acc, cur, wr, wc, fr, fq);
    else {
#pragma unroll
    for (int a = 0; a < 2; ++a)
#pragma unroll
        for (int b = 0; b < 2; ++b)
#pragma unroll
            for (int m = 0; m < 4; ++m)
#pragma unroll
                for (int n = 0; n < 2; ++n) acc[a][b][m][n] = (f32x4){0.f, 0.f, 0.f, 0.f};
    }
    bf16x8 At[4][2], B0[2][2], B1[2][2];
    const char* cA = (const char*)g.A + (size_t)cur.pm * tstep; const char* cB = (const char*)g.Bt + (size_t)cur.pn * tstep;
    S.a_ready(cur);
    if constexpr (SP2) {
        PG8_STAGE(PG8_SB(0, 0), cB, voffB); PG8_STAGE(PG8_SB(0, 1), cB + hstep, voffB); PG8_STAGE(PG8_SA(0, 0), cA, voffA); PG8_STAGE(PG8_SA(0, 1), cA + hstep, voffA);
        if (wr == 1) PG8_BAR;
        PG8_WAIT_V(2); PG8_BAR;
        PG8_STAGE(PG8_SB(1, 0), cB + kstep, voffB); PG8_STAGE(PG8_SA(1, 0), cA + kstep, voffA); PG8_STAGE(PG8_SB(1, 1), cB + hstep + kstep, voffB);
        PG8_WAIT_V(6); PG8_BAR;
    } else {
        PG8_STAGE(PG8_SB(0, 0), cB, voffB); PG8_STAGE(PG8_SA(0, 0), cA, voffA); PG8_STAGE(PG8_SB(0, 1), cB + hstep, voffB); PG8_STAGE(PG8_SA(0, 1), cA + hstep, voffA);
        if (wr == 1) PG8_BAR;
        PG8_WAIT_V(4); PG8_BAR;
        PG8_STAGE(PG8_SB(1, 0), cB + kstep, voffB); PG8_STAGE(PG8_SA(1, 0), cA + kstep, voffA); PG8_STAGE(PG8_SB(1, 1), cB + hstep + kstep, voffB);
        PG8_WAIT_V(6); PG8_BAR;
    }
    for (;;) {
        const bool has_next = S.next(ui + 1, nxt);
        const char* nA = has_next ? (const char*)g.A + (size_t)nxt.pm * tstep : cA; const char* nB = has_next ? (const char*)g.Bt + (size_t)nxt.pn * tstep : cB;
        for (int t = 0; t < nt; t += 2) {
            const bool last = (t == nt - 2);
            const char* a1 = cA + (size_t)(t + 1) * kstep;
            const char* a2 = last ? nA : cA + (size_t)(t + 2) * kstep; const char* b2 = last ? nB : cB + (size_t)(t + 2) * kstep;
            const char* a3 = a2 + kstep; const char* b3 = b2 + kstep;
            if (last && has_next) S.a_ready(nxt);
            if constexpr (SP2) {
            PG8_LDB(B0, 0, 0); PG8_LDB(B1, 0, 1); PG8_SCHED; PG8_LDA(At, 0, 0); PG8_STAGE(PG8_SA(1, 1), a1 + hstep, voffA);
            PG8_WAIT_V(8); PG8_WAIT_L(0); PG8_BAR; PG8_MMA(0, 0, At, B0); PG8_MMA(0, 1, At, B1); PG8_BAR; PG8_SCHED;
            PG8_LDA(At, 0, 1); PG8_STAGE(PG8_SB(0, 0), b2, voffB); PG8_STAGE(PG8_SB(0, 1), b2 + hstep, voffB); PG8_STAGE(PG8_SA(0, 0), a2, voffA);
            PG8_WAIT_V(8); PG8_WAIT_L(0); PG8_BAR; PG8_MMA(1, 0, At, B0); PG8_MMA(1, 1, At, B1); PG8_BAR; PG8_SCHED;
            PG8_LDB(B0, 1, 0); PG8_LDB(B1, 1, 1); PG8_SCHED; PG8_LDA(At, 1, 0); PG8_STAGE(PG8_SA(0, 1), a2 + hstep, voffA);
            PG8_WAIT_V(8); PG8_WAIT_L(0); PG8_BAR; PG8_MMA(0, 0, At, B0); PG8_MMA(0, 1, At, B1); PG8_BAR; PG8_SCHED;
            PG8_LDA(At, 1, 1); PG8_STAGE(PG8_SB(1, 0), b3, voffB); PG8_STAGE(PG8_SB(1, 1), b3 + hstep, voffB); PG8_STAGE(PG8_SA(1, 0), a3, voffA);
            PG8_WAIT_V(8); PG8_WAIT_L(0); PG8_BAR; PG8_MMA(1, 0, At, B0); PG8_MMA(1, 1, At, B1); PG8_BAR; PG8_SCHED;
            } else {
            PG8_LDB(B0, 0, 0); PG8_SCHED; PG8_LDA(At, 0, 0); PG8_STAGE(PG8_SA(1, 1), a1 + hstep, voffA);
            PG8_WAIT_L(8); PG8_BAR; PG8_WAIT_L(0); PG8_MMA(0, 0, At, B0); PG8_BAR; PG8_SCHED;
            PG8_LDB(B1, 0, 1); PG8_STAGE(PG8_SB(0, 0), b2, voffB);
            PG8_BAR; PG8_WAIT_L(0); PG8_MMA(0, 1, At, B1); PG8_BAR;
            PG8_LDA(At, 0, 1); PG8_STAGE(PG8_SA(0, 0), a2, voffA);
            PG8_BAR; PG8_WAIT_L(0); PG8_MMA(1, 0, At, B0); PG8_BAR; PG8_SCHED;
            PG8_STAGE(PG8_SB(0, 1), b2 + hstep, voffB);
            PG8_WAIT_V(6); PG8_BAR; PG8_MMA(1, 1, At, B1); PG8_BAR;
            PG8_LDB(B0, 1, 0); PG8_SCHED; PG8_LDA(At, 1, 0); PG8_STAGE(PG8_SA(0, 1), a2 + hstep, voffA);
            PG8_WAIT_L(8); PG8_BAR; PG8_WAIT_L(0); PG8_MMA(0, 0, At, B0); PG8_BAR; PG8_SCHED;
            PG8_LDB(B1, 1, 1); PG8_STAGE(PG8_SB(1, 0), b3, voffB);
            PG8_BAR; PG8_WAIT_L(0); PG8_MMA(0, 1, At, B1); PG8_BAR;
            PG8_LDA(At, 1, 1); PG8_STAGE(PG8_SA(1, 0), a3, voffA);
            PG8_BAR; PG8_WAIT_L(0); PG8_MMA(1, 0, At, B0); PG8_BAR; PG8_SCHED;
            PG8_STAGE(PG8_SB(1, 1), b3 + hstep, voffB);
            PG8_WAIT_V(6); PG8_BAR; PG8_MMA(1, 1, At, B1); PG8_BAR;
            }
        }
        if constexpr (ALIGN_EPI) { if (wr == 0) PG8_BAR; }
        if constexpr (!Epi::AFTER_DRAIN) { E(acc, cur, wr, wc, fr, fq); S.done(cur); }
        if (!has_next) break;
        if constexpr (Epi::INIT) E.init(acc, nxt, wr, wc, fr, fq);
        else {
#pragma unroll
        for (int a = 0; a < 2; ++a)
#pragma unroll
            for (int b = 0; b < 2; ++b)
#pragma unroll
                for (int m = 0; m < 4; ++m)
#pragma unroll
                    for (int n = 0; n < 2; ++n) acc[a][b][m][n] = (f32x4){0.f, 0.f, 0.f, 0.f};
        }
        cur = nxt; cA = nA; cB = nB; ++ui;
        if constexpr (ALIGN_EPI) { if (wr == 1) PG8_BAR; }
    }
    PG8_WAIT_V(0);
    if constexpr (!ALIGN_EPI) { if (wr == 0) PG8_BAR; }
    PG8_BAR;
    if constexpr (Epi::AFTER_DRAIN) { E.fused(acc, cur, wr, wc, fr, fq, lds, wid, lane); S.done(cur); }
#undef PG8_SA
#undef PG8_SB
#undef PG8_STAGE
#undef PG8_LDA
#undef PG8_LDB
#undef PG8_MMA
#undef PG8_WAIT_V
#undef PG8_WAIT_L
#undef PG8_BAR
#undef PG8_SCHED
}
}

constexpr int BATCH = 2, SEQ = 4096, DM = 2048, MTOK = BATCH * SEQ;
constexpr int AW = 1024, PW = 1024, NIN = 6144, HD = 64, NH = 8;
constexpr float EPSN = 1e-6f;
constexpr float LAM_INIT = 0.2f;
constexpr float LOG2E = 1.4426950408889634f;

constexpr size_t MiB = 1u << 20;
constexpr size_t WS_ROPE = 0;
constexpr size_t WS_CTL = 512 * 1024, CTL_BYTES = 16384;
constexpr size_t WS_WPT = 1 * MiB;
constexpr size_t WS_WIT = 2 * MiB;
constexpr size_t WS_WOT = 26 * MiB;
constexpr size_t WS_XS = 34 * MiB;
constexpr size_t WS_Q = 66 * MiB, WS_K = 82 * MiB, WS_V = 98 * MiB, WS_GA = 114 * MiB, WS_U = 130 * MiB, WS_GP = 146 * MiB;
constexpr size_t WS_MIX = 162 * MiB;
constexpr size_t WS_END = 194 * MiB;

#define LAS __attribute__((address_space(3)))
typedef unsigned short bf16_t;
typedef float f32x4 __attribute__((ext_vector_type(4)));
typedef float f32x2 __attribute__((ext_vector_type(2)));
typedef unsigned u32x4 __attribute__((ext_vector_type(4)));
typedef unsigned u32x2 __attribute__((ext_vector_type(2)));
typedef short bf16x8 __attribute__((ext_vector_type(8)));
typedef short s16x4 __attribute__((ext_vector_type(4)));
typedef float f32x16 __attribute__((ext_vector_type(16)));

typedef __bf16 bf16x2_cv __attribute__((ext_vector_type(2)));
__device__ __forceinline__ unsigned cvtpk(float lo, float hi) { f32x2 v = {lo, hi}; bf16x2_cv b = __builtin_convertvector(v, bf16x2_cv); return __builtin_bit_cast(unsigned, b); }
__device__ __forceinline__ float bf_lo(unsigned w) { return __uint_as_float(w << 16); }
__device__ __forceinline__ float bf_hi(unsigned w) { return __uint_as_float(w & 0xffff0000u); }
__device__ __forceinline__ float silu_f(float x) { return x * __builtin_amdgcn_rcpf(1.0f + __builtin_amdgcn_exp2f(-x * LOG2E)); }
__device__ __forceinline__ float wave_sum(float v) {
#pragma unroll
    for (int o = 1; o < 64; o <<= 1) v += __shfl_xor(v, o);
    return v;
}
__device__ __forceinline__ float wave_max(float v) {
#pragma unroll
    for (int o = 1; o < 64; o <<= 1) v = fmaxf(v, __shfl_xor(v, o));
    return v;
}

struct EpiProj {
    static constexpr bool PERM = true, AFTER_DRAIN = false, INIT = false;
    bf16_t *Q, *K, *V, *GA, *U, *GP; const float *qw, *kw; const float* rope; float qscale;
    __device__ __forceinline__ void operator()(const f32x4 (&acc)[2][2][4][2], const pg8::Unit& u, int wr, int wc, int fr, int fq) const {
        const int type = u.pn >> 2;
        const int col0 = (u.pn & 3) * 256 + wc * 64 + fq * 8;
        const int row0 = u.pm * 256 + wr * 64 + fr;
        if (type <= 1) {
            const float* wsrc = (type == 0 ? qw : kw) + fq * 8;
            const f32x4 w00 = *(const f32x4*)(wsrc), w01 = *(const f32x4*)(wsrc + 4), w10 = *(const f32x4*)(wsrc + 32), w11 = *(const f32x4*)(wsrc + 36);
            bf16_t* dsth = (type == 0 ? Q : K) + (size_t)(((u.pm * 256) >> 12) * NH + (col0 >> 7)) * SEQ * 128 + (col0 & 127);
            const float sc = (type == 0) ? qscale : 1.0f;
            const float sgn = (fq == 0) ? -1.0f : 1.0f;
#pragma unroll
            for (int ai = 0; ai < 2; ++ai) {
                f32x4 rc[4][4];
#pragma unroll
                for (int m = 0; m < 4; ++m) { const float* rp = rope + ((row0 + ai * 128 + m * 16) & (SEQ - 1)) * 16;
#pragma unroll
                    for (int q = 0; q < 4; ++q) rc[m][q] = (fq < 2) ? *(const f32x4*)(rp + 4 * q) : (f32x4){0.f, 0.f, 0.f, 0.f}; }
                asm volatile("" ::: "memory");
#pragma unroll
                for (int m = 0; m < 4; ++m) {
                    const int row = row0 + ai * 128 + m * 16, pos = row & (SEQ - 1);
                    f32x4 v00 = acc[ai][0][m][0], v01 = acc[ai][0][m][1], v10 = acc[ai][1][m][0], v11 = acc[ai][1][m][1];
                    float ss = (v00[0] * v00[0] + v00[1] * v00[1]) + (v00[2] * v00[2] + v00[3] * v00[3]);
                    ss += (v01[0] * v01[0] + v01[1] * v01[1]) + (v01[2] * v01[2] + v01[3] * v01[3]);
                    ss += (v10[0] * v10[0] + v10[1] * v10[1]) + (v10[2] * v10[2] + v10[3] * v10[3]);
                    ss += (v11[0] * v11[0] + v11[1] * v11[1]) + (v11[2] * v11[2] + v11[3] * v11[3]);
                    ss += __shfl_xor(ss, 16); ss += __shfl_xor(ss, 32);
                    const float rs = 1.0f / sqrtf(ss * (1.0f / 64.0f) + EPSN);
                    v00 = v00 * rs * w00; v01 = v01 * rs * w01; v10 = v10 * rs * w10; v11 = v11 * rs * w11;
                    f32x4 o00, o01;
#pragma unroll
                    for (int i = 0; i < 4; ++i) { o00[i] = __shfl_xor(v00[i], 16); o01[i] = __shfl_xor(v01[i], 16); }
                    if (fq < 2) {
                        const f32x4 c0 = rc[m][0], c1 = rc[m][1], s0 = rc[m][2], s1 = rc[m][3];
                        v00 = v00 * c0 + (o00 * s0) * sgn; v01 = v01 * c1 + (o01 * s1) * sgn;
                    }
                    v00 = v00 * sc; v01 = v01 * sc; v10 = v10 * sc; v11 = v11 * sc;
                    u32x4 a, b;
                    a.x = cvtpk(v00[0], v00[1]); a.y = cvtpk(v00[2], v00[3]); a.z = cvtpk(v01[0], v01[1]); a.w = cvtpk(v01[2], v01[3]);
                    b.x = cvtpk(v10[0], v10[1]); b.y = cvtpk(v10[2], v10[3]); b.z = cvtpk(v11[0], v11[1]); b.w = cvtpk(v11[2], v11[3]);
                    bf16_t* rowp = dsth + (size_t)pos * 128;
                    *(u32x4*)(rowp) = a; *(u32x4*)(rowp + 32) = b;
                }
                asm volatile("" ::: "memory");
            }
        } else {
            bf16_t* dst = (type == 2) ? V : (type == 3) ? GA : (type == 4) ? U : GP;
            const bool act = (type == 3) || (type == 5);
            const bool hm = (type == 2);
            const int rstride = hm ? 128 : AW, rmask = hm ? (SEQ - 1) : 0x7fffffff;
            dst += hm ? (size_t)(((u.pm * 256) >> 12) * NH + (col0 >> 7)) * SEQ * 128 + (col0 & 127) : (size_t)col0;
#pragma unroll
            for (int ai = 0; ai < 2; ++ai)
#pragma unroll
                for (int m = 0; m < 4; ++m) {
                    const int row = row0 + ai * 128 + m * 16;
                    bf16_t* rowp = dst + (size_t)(row & rmask) * rstride;
#pragma unroll
                    for (int bj = 0; bj < 2; ++bj) {
                        f32x4 v0 = acc[ai][bj][m][0], v1 = acc[ai][bj][m][1];
                        if (act) {
#pragma unroll
                            for (int i = 0; i < 4; ++i) { v0[i] = silu_f(v0[i]); v1[i] = silu_f(v1[i]); }
                        }
                        u32x4 a; a.x = cvtpk(v0[0], v0[1]); a.y = cvtpk(v0[2], v0[3]); a.z = cvtpk(v1[0], v1[1]); a.w = cvtpk(v1[2], v1[3]);
                        *(u32x4*)(rowp + bj * 32) = a;
                    }
                }
        }
    }
};
struct EpiOut {
    static constexpr bool PERM = true, AFTER_DRAIN = false, INIT = true;
    const float* x; float* out;
    __device__ __forceinline__ void init(f32x4 (&acc)[2][2][4][2], const pg8::Unit& u, int wr, int wc, int fr, int fq) const {
        const int row0 = u.pm * 256 + wr * 64 + fr, col0 = u.pn * 256 + wc * 32 + fq * 8;
#pragma unroll
        for (int ai = 0; ai < 2; ++ai)
#pragma unroll
            for (int m = 0; m < 4; ++m) { const size_t off = (size_t)(row0 + ai * 128 + m * 16) * DM + col0;
#pragma unroll
                for (int bj = 0; bj < 2; ++bj) { acc[ai][bj][m][0] = *(const f32x4*)(x + off + bj * 128); acc[ai][bj][m][1] = *(const f32x4*)(x + off + bj * 128 + 4); } }
    }
    __device__ __forceinline__ void operator()(const f32x4 (&acc)[2][2][4][2], const pg8::Unit& u, int wr, int wc, int fr, int fq) const {
        const int row0 = u.pm * 256 + wr * 64 + fr, col0 = u.pn * 256 + wc * 32 + fq * 8;
#pragma unroll
        for (int ai = 0; ai < 2; ++ai)
#pragma unroll
            for (int m = 0; m < 4; ++m) { const size_t off = (size_t)(row0 + ai * 128 + m * 16) * DM + col0;
#pragma unroll
                for (int bj = 0; bj < 2; ++bj) { *(f32x4*)(out + off + bj * 128) = acc[ai][bj][m][0]; *(f32x4*)(out + off + bj * 128 + 4) = acc[ai][bj][m][1]; } }
    }
};

namespace att {
constexpr int KVBLK = 64, NT = SEQ / KVBLK, LD = 128;
constexpr int SHM_V = KVBLK * 128 * 2, SHM_K = KVBLK * 128 * 2;
constexpr int OFF_V = 0, OFF_K = 2 * SHM_V, OFF_WS = 2 * SHM_V + 2 * SHM_K;
#define KSWZ(row, colB) ((row) * 256 + ((colB) ^ (((row) & 7) << 4)))
#define SBAR() __builtin_amdgcn_sched_barrier(0)
__device__ __forceinline__ int crow(int r, int hi) { return (r & 3) + 8 * (r >> 2) + 4 * hi; }
__device__ __forceinline__ int v_st(int k, int c) { const int kk = (k & ~0xC) | ((k & 4) << 1) | ((k & 8) >> 1); return ((kk >> 3) * 4 + (c >> 5)) * 512 + ((kk & 7) * 32 + (c & 31)) * 2; }
__device__ __forceinline__ int v_rd_base(int lane) { return ((lane & 3) << 3) | (((lane >> 2) & 3) << 6) | (((lane >> 4) & 1) << 5) | (((lane >> 5) & 1) << 8); }
constexpr int v_rd_off(int d0, int ks, int half) { return d0 * 512 + ks * 4096 + half * 2048; }
template <int OFF> __device__ __forceinline__ s16x4 tr_read(int vb) {
    s16x4 r; asm volatile("ds_read_b64_tr_b16 %0, %1 offset:%2" : "=&v"(r) : "v"(vb), "i"(OFF) : "memory"); return r;
}
template <int D0> __device__ __forceinline__ void pv_one(f32x16& od, int vb, bf16x8 pa0, bf16x8 pa1, bf16x8 pa2, bf16x8 pa3) {
    const s16x4 l0 = tr_read<v_rd_off(D0, 0, 0)>(vb), h0 = tr_read<v_rd_off(D0, 0, 1)>(vb), l1 = tr_read<v_rd_off(D0, 1, 0)>(vb), h1 = tr_read<v_rd_off(D0, 1, 1)>(vb);
    const s16x4 l2 = tr_read<v_rd_off(D0, 2, 0)>(vb), h2 = tr_read<v_rd_off(D0, 2, 1)>(vb), l3 = tr_read<v_rd_off(D0, 3, 0)>(vb), h3 = tr_read<v_rd_off(D0, 3, 1)>(vb);
    asm volatile("s_waitcnt lgkmcnt(0)" ::: "memory"); SBAR();
#define PK(L, H) (bf16x8){L[0], L[1], L[2], L[3], H[0], H[1], H[2], H[3]}
    od = __builtin_amdgcn_mfma_f32_32x32x16_bf16(pa0, PK(l0, h0), od, 0, 0, 0);
    od = __builtin_amdgcn_mfma_f32_32x32x16_bf16(pa1, PK(l1, h1), od, 0, 0, 0);
    od = __builtin_amdgcn_mfma_f32_32x32x16_bf16(pa2, PK(l2, h2), od, 0, 0, 0);
    od = __builtin_amdgcn_mfma_f32_32x32x16_bf16(pa3, PK(l3, h3), od, 0, 0, 0);
#undef PK
}
__device__ __forceinline__ void pv_d0(f32x16* o, int vb, bf16x8 pa0, bf16x8 pa1, bf16x8 pa2, bf16x8 pa3) {
    pv_one<0>(o[0], vb, pa0, pa1, pa2, pa3); pv_one<1>(o[1], vb, pa0, pa1, pa2, pa3); pv_one<2>(o[2], vb, pa0, pa1, pa2, pa3); pv_one<3>(o[3], vb, pa0, pa1, pa2, pa3);
}
__device__ __forceinline__ void qkt(f32x16& p0, f32x16& p1, const char* Ks, const bf16x8* qr, int comp, int r32, int hi) {
    const f32x16 zero = f32x16{};
#pragma unroll
    for (int d = 0; d < 4; ++d) { const int cb = ((comp * 4 + d) * 16 + hi * 8) * 2;
        const bf16x8 b0 = *reinterpret_cast<const bf16x8*>(Ks + KSWZ(r32, cb));
        const bf16x8 b1 = *reinterpret_cast<const bf16x8*>(Ks + KSWZ(32 + r32, cb));
        if (d == 0) { p0 = __builtin_amdgcn_mfma_f32_32x32x16_bf16(b0, qr[0], zero, 0, 0, 0); p1 = __builtin_amdgcn_mfma_f32_32x32x16_bf16(b1, qr[0], zero, 0, 0, 0); }
        else { p0 = __builtin_amdgcn_mfma_f32_32x32x16_bf16(b0, qr[d], p0, 0, 0, 0); p1 = __builtin_amdgcn_mfma_f32_32x32x16_bf16(b1, qr[d], p1, 0, 0, 0); } }
}
template <bool SHIFT> __device__ __forceinline__ void partialSM(f32x16& p0, float negM2) {
#pragma unroll
    for (int r = 0; r < 16; ++r) p0[r] = __builtin_amdgcn_exp2f(SHIFT ? p0[r] + negM2 : p0[r]);
}
template <bool SHIFT> __device__ __forceinline__ void finishSM(f32x16& p0, f32x16& p1, float negM2, float& l_reg, bf16x8& pa0, bf16x8& pa1, bf16x8& pa2, bf16x8& pa3) {
#pragma unroll
    for (int r = 0; r < 16; ++r) p1[r] = __builtin_amdgcn_exp2f(SHIFT ? p1[r] + negM2 : p1[r]);
    float ps = 0.f;
#pragma unroll
    for (int r = 0; r < 16; ++r) ps += p0[r];
#pragma unroll
    for (int r = 0; r < 16; ++r) ps += p1[r];
    l_reg += ps;
#define PK4(P, BASE, OUT) do { unsigned a0 = cvtpk(P[BASE + 0], P[BASE + 1]), a1 = cvtpk(P[BASE + 2], P[BASE + 3]);   \
    unsigned b0 = cvtpk(P[BASE + 4], P[BASE + 5]), b1 = cvtpk(P[BASE + 6], P[BASE + 7]);                              \
    auto r0 = __builtin_amdgcn_permlane32_swap(a0, b0, false, false); auto r1 = __builtin_amdgcn_permlane32_swap(a1, b1, false, false); \
    u32x4 w = {r0[0], r1[0], r0[1], r1[1]}; OUT = *reinterpret_cast<bf16x8*>(&w); } while (0)
    PK4(p0, 0, pa0); PK4(p0, 8, pa1); PK4(p1, 0, pa2); PK4(p1, 8, pa3);
#undef PK4
}

struct Tensors { const bf16_t *Q, *K, *V, *GA; bf16_t* MIX; const float* subw; float lam, negM2; };
__device__ __forceinline__ void epilogue(f32x16 (&o)[4], float l_reg, int b, int h, int qb, const Tensors& T, char* lds);

template <bool SHIFT> __device__ __forceinline__ void unit(int b, int h, int qb, const Tensors& T, char* lds) {
    const float negM2 = T.negM2;
    int tid = threadIdx.x; asm volatile("" : "+v"(tid));
    const int wid = __builtin_amdgcn_readfirstlane(tid >> 6), lane = tid & 63, r32 = lane & 31, hi = lane >> 5;
    const int comp = wid >> 2, rw = wid & 3;
    char* V_lds = lds + OFF_V; char* K_lds = lds + OFF_K;
    float* wsf = (float*)(lds + OFF_WS) + wid * 64;
    const long rowbase = (long)b * SEQ; const int q0 = qb * 128;
    const long hb = (long)(b * NH + h) * SEQ;
    const bf16_t* Kh = T.K + hb * LD; const bf16_t* Vh = T.V + hb * LD;
    bf16x8 qr[4];
    { const bf16_t* Qw = T.Q + (hb + q0 + rw * 32 + r32) * LD + comp * 64 + hi * 8;
#pragma unroll
      for (int d = 0; d < 4; ++d) qr[d] = *reinterpret_cast<const bf16x8*>(Qw + d * 16); }
    float l_reg = 0.f; f32x16 o[4];
#pragma unroll
    for (int d = 0; d < 4; ++d) o[d] = f32x16{};
    const int sr = tid >> 4, sc = (tid & 15) * 8, vst0 = v_st(sr, sc), vst1 = v_st(32 + sr, sc);
    const int vb0 = (int)(uintptr_t)V_lds + v_rd_base(lane);
    struct { bf16x8 vs0, vs1, ks0, ks1; } sr_[2];
#define LD8(p) (*reinterpret_cast<const bf16x8*>(p))
#define SLOAD(i, k0) do { sr_[i].vs0 = LD8(&Vh[(long)((k0) + sr) * LD + sc]); sr_[i].vs1 = LD8(&Vh[(long)((k0) + 32 + sr) * LD + sc]); \
    sr_[i].ks0 = LD8(&Kh[(long)((k0) + sr) * LD + sc]); sr_[i].ks1 = LD8(&Kh[(long)((k0) + 32 + sr) * LD + sc]); } while (0)
#define SWRITE(bb, i) do { *(bf16x8*)(V_lds + (bb) * SHM_V + vst0) = sr_[i].vs0;          \
    *(bf16x8*)(V_lds + (bb) * SHM_V + vst1) = sr_[i].vs1; const int kc = sc * 2;               \
    *(bf16x8*)(K_lds + (bb) * SHM_K + KSWZ(sr, kc)) = sr_[i].ks0;                       \
    *(bf16x8*)(K_lds + (bb) * SHM_K + KSWZ(32 + sr, kc)) = sr_[i].ks1; } while (0)
#define SWAIT() asm volatile("s_waitcnt vmcnt(4)" ::: "memory")
    f32x16 pA0, pA1, pB0, pB1; bf16x8 pa0, pa1, pa2, pa3;
    constexpr int SE = 0, SO = 1;
    SLOAD(SE, 0); asm volatile("s_waitcnt vmcnt(0)" ::: "memory"); SWRITE(0, SE); __syncthreads();
    qkt(pA0, pA1, K_lds, qr, comp, r32, hi); partialSM<SHIFT>(pA0, negM2);
    SLOAD(SO, KVBLK); SLOAD(SE, 2 * KVBLK);
    SWAIT(); SWRITE(1, SO); __syncthreads();
#pragma unroll 1
    for (int j = 1; j + 1 < NT; j += 2) {
        SBAR(); qkt(pB0, pB1, K_lds + SHM_K, qr, comp, r32, hi);
        finishSM<SHIFT>(pA0, pA1, negM2, l_reg, pa0, pa1, pa2, pa3); SBAR();
        SLOAD(SO, (j + 2) * KVBLK); SBAR();
        pv_d0(o, vb0, pa0, pa1, pa2, pa3); partialSM<SHIFT>(pB0, negM2);
        __syncthreads(); SWAIT(); SWRITE(0, SE);
        __syncthreads();
        SBAR(); qkt(pA0, pA1, K_lds, qr, comp, r32, hi);
        finishSM<SHIFT>(pB0, pB1, negM2, l_reg, pa0, pa1, pa2, pa3); SBAR();
        SLOAD(SE, (j + 3 < NT ? j + 3 : NT - 1) * KVBLK); SBAR();
        pv_d0(o, vb0 + SHM_V, pa0, pa1, pa2, pa3); partialSM<SHIFT>(pA0, negM2);
        __syncthreads(); SWAIT(); SWRITE(1, SO);
        __syncthreads();
    }
    SBAR(); qkt(pB0, pB1, K_lds + SHM_K, qr, comp, r32, hi);
    finishSM<SHIFT>(pA0, pA1, negM2, l_reg, pa0, pa1, pa2, pa3); SBAR();
    pv_d0(o, vb0, pa0, pa1, pa2, pa3); partialSM<SHIFT>(pB0, negM2);
    finishSM<SHIFT>(pB0, pB1, negM2, l_reg, pa0, pa1, pa2, pa3); SBAR();
    pv_d0(o, vb0 + SHM_V, pa0, pa1, pa2, pa3);
#undef SLOAD
#undef SWRITE
#undef SWAIT
#undef LD8
    epilogue(o, l_reg, b, h, qb, T, lds);
}
__device__ __forceinline__ void epilogue(f32x16 (&o)[4], float l_reg, int b, int h, int qb, const Tensors& T, char* lds) {
    int tid = threadIdx.x; asm volatile("" : "+v"(tid));
    const int wid = __builtin_amdgcn_readfirstlane(tid >> 6), lane = tid & 63, r32 = lane & 31, hi = lane >> 5;
    const int comp = wid >> 2, rw = wid & 3;
    float* wsf = (float*)(lds + OFF_WS) + wid * 64;
    const long rowbase = (long)b * SEQ; const int q0 = qb * 128;
    { auto rr = __builtin_amdgcn_permlane32_swap(__float_as_uint(l_reg), __float_as_uint(l_reg), false, false); l_reg = __uint_as_float(rr[0]) + __uint_as_float(rr[1]); }
    if (hi == 0) wsf[r32] = l_reg;
    asm volatile("s_waitcnt lgkmcnt(0)" ::: "memory");
    float rli[16];
#pragma unroll
    for (int r = 0; r < 16; ++r) rli[r] = __builtin_amdgcn_rcpf(wsf[crow(r, hi)]);
    __syncthreads();
    float* X = (float*)lds + rw * 4096;
    if (comp == 1) {
        const float lam = T.lam;
#pragma unroll
        for (int r = 0; r < 16; ++r) { const float f = rli[r] * lam;
#pragma unroll
            for (int d = 0; d < 4; ++d) X[crow(r, hi) * 128 + d * 32 + r32] = o[d][r] * f; }
    }
    __syncthreads();
    if (comp == 0) {
        float sw[4];
#pragma unroll
        for (int d = 0; d < 4; ++d) sw[d] = T.subw[d * 32 + r32] * (1.0f - LAM_INIT);
#pragma unroll
        for (int r = 0; r < 16; ++r) {
            float a[4]; float ss = 0.f;
#pragma unroll
            for (int d = 0; d < 4; ++d) { a[d] = o[d][r] * rli[r] - X[crow(r, hi) * 128 + d * 32 + r32]; ss += a[d] * a[d]; }
            ss += __shfl_xor(ss, 1); ss += __shfl_xor(ss, 2); ss += __shfl_xor(ss, 4); ss += __shfl_xor(ss, 8); ss += __shfl_xor(ss, 16);
            const float rs = 1.0f / sqrtf(ss * (1.0f / 128.0f) + EPSN);
#pragma unroll
            for (int d = 0; d < 4; ++d) X[crow(r, hi) * 128 + d * 32 + r32] = a[d] * rs * sw[d];
        }
    }
    __syncthreads();
#pragma unroll
    for (int i = 0; i < 4; ++i) {
        const int idx = i * 64 + lane, row = comp * 16 + (idx >> 4), ch = idx & 15;
        const f32x4 z0 = *(const f32x4*)(X + row * 128 + ch * 8), z1 = *(const f32x4*)(X + row * 128 + ch * 8 + 4);
        const long grow = rowbase + q0 + rw * 32 + row;
        const u32x4 g = *(const u32x4*)(T.GA + grow * AW + h * 128 + ch * 8);
        u32x4 w;
        w.x = cvtpk(z0[0] * bf_lo(g.x), z0[1] * bf_hi(g.x)); w.y = cvtpk(z0[2] * bf_lo(g.y), z0[3] * bf_hi(g.y));
        w.z = cvtpk(z1[0] * bf_lo(g.z), z1[1] * bf_hi(g.z)); w.w = cvtpk(z1[2] * bf_lo(g.w), z1[3] * bf_hi(g.w));
        *(u32x4*)(T.MIX + grow * DM + h * 128 + ch * 8) = w;
    }
    __syncthreads();
}
}


namespace att2 {
#ifndef DEBUG_SYNC_COPY
#define DEBUG_SYNC_COPY 0
#endif
using att::crow; using att::Tensors; using att::tr_read; using att::v_rd_off; using att::v_rd_base;
constexpr int NT = SEQ / 64, SHM = 16384;
constexpr int OFF_Q = 0, OFF_V = 65536, OFF_K = 98304, OFF_WS = 131072;
typedef LAS unsigned char* ldsp;
__device__ __forceinline__ void glds16s(unsigned voff, const void* sbase, unsigned lds_dst) { unsigned keep;
    asm volatile("s_mov_b32 %0, m0\n\ts_mov_b32 m0, %3\n\ts_nop 0\n\tglobal_load_lds_dwordx4 %1, %2\n\ts_mov_b32 m0, %0" : "=&s"(keep) : "v"(voff), "s"(sbase), "s"(lds_dst) : "memory"); }
typedef __bf16 bf16x2_t __attribute__((ext_vector_type(2)));
__device__ __forceinline__ unsigned cvtpk_s(float lo, float hi) { f32x2 v = {lo, hi}; bf16x2_t b = __builtin_convertvector(v, bf16x2_t); return __builtin_bit_cast(unsigned, b); }
template <int H, int D0> __device__ __forceinline__ void v_rd4(s16x4 (&f)[4], int vb) {
    f[0] = tr_read<v_rd_off(D0, 2 * H, 0)>(vb); f[1] = tr_read<v_rd_off(D0, 2 * H, 1)>(vb); f[2] = tr_read<v_rd_off(D0, 2 * H + 1, 0)>(vb); f[3] = tr_read<v_rd_off(D0, 2 * H + 1, 1)>(vb);
}
__device__ __forceinline__ void pv_mma(f32x16& oa, f32x16& ob, const s16x4 (&f)[4], const bf16x8 (&pa)[2], const bf16x8 (&pb)[2]) {
#define PK(L, H_) (bf16x8){L[0], L[1], L[2], L[3], H_[0], H_[1], H_[2], H_[3]}
    const bf16x8 v0 = PK(f[0], f[1]), v1 = PK(f[2], f[3]);
#undef PK
    oa = __builtin_amdgcn_mfma_f32_32x32x16_bf16(pa[0], v0, oa, 0, 0, 0);
    ob = __builtin_amdgcn_mfma_f32_32x32x16_bf16(pb[0], v0, ob, 0, 0, 0);
    oa = __builtin_amdgcn_mfma_f32_32x32x16_bf16(pa[1], v1, oa, 0, 0, 0);
    ob = __builtin_amdgcn_mfma_f32_32x32x16_bf16(pb[1], v1, ob, 0, 0, 0);
}
template <int H> __device__ __forceinline__ void pv_half(f32x16 (&o0)[4], f32x16 (&o1)[4], int vb, const bf16x8 (&pa)[2], const bf16x8 (&pb)[2]) {
    s16x4 fa[4], fb[4];
    SBAR();
    v_rd4<H, 0>(fa, vb); v_rd4<H, 1>(fb, vb);
    asm volatile("s_waitcnt lgkmcnt(4)" ::: "memory"); SBAR();
    pv_mma(o0[0], o1[0], fa, pa, pb); SBAR();
    v_rd4<H, 2>(fa, vb);
    asm volatile("s_waitcnt lgkmcnt(4)" ::: "memory"); SBAR();
    pv_mma(o0[1], o1[1], fb, pa, pb); SBAR();
    v_rd4<H, 3>(fb, vb);
    asm volatile("s_waitcnt lgkmcnt(4)" ::: "memory"); SBAR();
    pv_mma(o0[2], o1[2], fa, pa, pb); SBAR();
    asm volatile("s_waitcnt lgkmcnt(0)" ::: "memory"); SBAR();
    pv_mma(o0[3], o1[3], fb, pa, pb); SBAR();
}
template <int C, int H> __device__ __forceinline__ void qkt_half(f32x16& p, ldsp Kb, ldsp Qw, const int (&fa)[4]) {
    const f32x16 zero = f32x16{};
#pragma unroll
    for (int d = 0; d < 4; ++d) {
        const bf16x8 q = *(const LAS bf16x8*)(Qw + fa[d] + C * 128);
        const bf16x8 kf = *(const LAS bf16x8*)(Kb + fa[d] + C * 128 + H * 8192);
        if (d == 0) p = __builtin_amdgcn_mfma_f32_32x32x16_bf16(kf, q, zero, 0, 0, 0);
        else p = __builtin_amdgcn_mfma_f32_32x32x16_bf16(kf, q, p, 0, 0, 0); }
}
template <int C, int H> __device__ __forceinline__ void qkt_half_r(f32x16& p, ldsp Kb, const bf16x8 (&qa)[4], const int (&fa)[4]) {
    const f32x16 zero = f32x16{};
#pragma unroll
    for (int d = 0; d < 4; ++d) {
        const bf16x8 kf = *(const LAS bf16x8*)(Kb + fa[d] + C * 128 + H * 8192);
        if (d == 0) p = __builtin_amdgcn_mfma_f32_32x32x16_bf16(kf, qa[0], zero, 0, 0, 0);
        else p = __builtin_amdgcn_mfma_f32_32x32x16_bf16(kf, qa[d], p, 0, 0, 0); }
}
template <bool SHIFT> __device__ __forceinline__ void softmax_half(f32x16& p, float negM2, float& l_reg, bf16x8 (&pa)[2]) {
#pragma unroll
    for (int r = 0; r < 16; ++r) p[r] = __builtin_amdgcn_exp2f(SHIFT ? p[r] + negM2 : p[r]);
#pragma unroll
    for (int r = 0; r < 16; ++r) l_reg += p[r];
#define PK4(P, BASE, OUT) do { unsigned a0 = cvtpk_s(P[BASE + 0], P[BASE + 1]), a1 = cvtpk_s(P[BASE + 2], P[BASE + 3]);   \
    unsigned b0 = cvtpk_s(P[BASE + 4], P[BASE + 5]), b1 = cvtpk_s(P[BASE + 6], P[BASE + 7]);                              \
    auto r0 = __builtin_amdgcn_permlane32_swap(a0, b0, false, false); auto r1 = __builtin_amdgcn_permlane32_swap(a1, b1, false, false); \
    u32x4 w = {r0[0], r1[0], r0[1], r1[1]}; OUT = *reinterpret_cast<bf16x8*>(&w); } while (0)
    PK4(p, 0, pa[0]); PK4(p, 8, pa[1]);
#undef PK4
}
template <bool SHIFT, int H, class Mid> __device__ __forceinline__ void half_tile(ldsp Kb, int vb, ldsp Qw, const int (&fa)[4], const bf16x8 (&qa)[4], const bf16x8 (&qb_)[4], float negM2, f32x16 (&o0)[4], f32x16 (&o1)[4], float& l0, float& l1, Mid&& mid) {
    f32x16 sa, sb; bf16x8 pa[2], pb[2];
    asm volatile("" : "+v"(l0) : "v"(l1));
    qkt_half_r<0, H>(sa, Kb, qa, fa);
    qkt_half_r<1, H>(sb, Kb, qb_, fa);
    if (H == 1) {
#pragma unroll
        for (int i = 0; i < 8; ++i) { __builtin_amdgcn_sched_group_barrier(0x008, 1, 0); __builtin_amdgcn_sched_group_barrier(0x100, 2, 0); }
    }
    softmax_half<SHIFT>(sa, negM2, l0, pa);
    asm volatile("" : "+v"(l1) : "v"(l0));
    SBAR();
    s16x4 f0[4], f1[4], f2[4], f3[4];
    v_rd4<H, 0>(f0, vb); v_rd4<H, 1>(f1, vb); v_rd4<H, 2>(f2, vb); v_rd4<H, 3>(f3, vb);
    asm volatile("s_waitcnt lgkmcnt(0)" ::: "memory"); SBAR();
    mid();
    SBAR();
#define PK(L, H_) (bf16x8){L[0], L[1], L[2], L[3], H_[0], H_[1], H_[2], H_[3]}
    const bf16x8 v00 = PK(f0[0], f0[1]), v01 = PK(f0[2], f0[3]), v10 = PK(f1[0], f1[1]), v11 = PK(f1[2], f1[3]);
    const bf16x8 v20 = PK(f2[0], f2[1]), v21 = PK(f2[2], f2[3]), v30 = PK(f3[0], f3[1]), v31 = PK(f3[2], f3[3]);
#undef PK
    o0[0] = __builtin_amdgcn_mfma_f32_32x32x16_bf16(pa[0], v00, o0[0], 0, 0, 0);
    o0[1] = __builtin_amdgcn_mfma_f32_32x32x16_bf16(pa[0], v10, o0[1], 0, 0, 0);
    o0[2] = __builtin_amdgcn_mfma_f32_32x32x16_bf16(pa[0], v20, o0[2], 0, 0, 0);
    o0[3] = __builtin_amdgcn_mfma_f32_32x32x16_bf16(pa[0], v30, o0[3], 0, 0, 0);
    o0[0] = __builtin_amdgcn_mfma_f32_32x32x16_bf16(pa[1], v01, o0[0], 0, 0, 0);
    o0[1] = __builtin_amdgcn_mfma_f32_32x32x16_bf16(pa[1], v11, o0[1], 0, 0, 0);
    o0[2] = __builtin_amdgcn_mfma_f32_32x32x16_bf16(pa[1], v21, o0[2], 0, 0, 0);
    o0[3] = __builtin_amdgcn_mfma_f32_32x32x16_bf16(pa[1], v31, o0[3], 0, 0, 0);
    softmax_half<SHIFT>(sb, negM2, l1, pb);
#pragma unroll
    for (int i = 0; i < 8; ++i) { __builtin_amdgcn_sched_group_barrier(0x008, 1, 0); __builtin_amdgcn_sched_group_barrier(0x402, 6, 0); }
    o1[0] = __builtin_amdgcn_mfma_f32_32x32x16_bf16(pb[0], v00, o1[0], 0, 0, 0);
    o1[1] = __builtin_amdgcn_mfma_f32_32x32x16_bf16(pb[0], v10, o1[1], 0, 0, 0);
    o1[2] = __builtin_amdgcn_mfma_f32_32x32x16_bf16(pb[0], v20, o1[2], 0, 0, 0);
    o1[3] = __builtin_amdgcn_mfma_f32_32x32x16_bf16(pb[0], v30, o1[3], 0, 0, 0);
    o1[0] = __builtin_amdgcn_mfma_f32_32x32x16_bf16(pb[1], v01, o1[0], 0, 0, 0);
    o1[1] = __builtin_amdgcn_mfma_f32_32x32x16_bf16(pb[1], v11, o1[1], 0, 0, 0);
    o1[2] = __builtin_amdgcn_mfma_f32_32x32x16_bf16(pb[1], v21, o1[2], 0, 0, 0);
    o1[3] = __builtin_amdgcn_mfma_f32_32x32x16_bf16(pb[1], v31, o1[3], 0, 0, 0);
}
template <bool SHIFT, class Mid> __device__ __forceinline__ void tile(ldsp Kb, int vb, ldsp Qw, const int (&fa)[4], const bf16x8 (&qa)[4], const bf16x8 (&qb_)[4], float negM2, f32x16 (&o0)[4], f32x16 (&o1)[4], float& l0, float& l1, Mid&& mid) {
    half_tile<SHIFT, 0>(Kb, vb, Qw, fa, qa, qb_, negM2, o0, o1, l0, l1, [] {});
    half_tile<SHIFT, 1>(Kb, vb, Qw, fa, qa, qb_, negM2, o0, o1, l0, l1, mid);
}
__device__ __forceinline__ void epilogue2(f32x16 (&o0)[4], f32x16 (&o1)[4], float l0, float l1, int b, int h, int qb, const Tensors& T, char* lds);

template <bool SHIFT> __device__ __forceinline__ void unit(int b, int h, int qb, const Tensors& T, char* ldsc) {
    int tid = threadIdx.x; asm volatile("" : "+v"(tid));
    const int wid = __builtin_amdgcn_readfirstlane(tid >> 6), lane = tid & 63, r32 = lane & 31, hi = lane >> 5;
    ldsp lds = (ldsp)ldsc;
    const long hb = (long)(b * NH + h) * SEQ;
    const bf16_t* Kh = T.K + hb * 128; const bf16_t* Vh = T.V + hb * 128;
    const unsigned lds0 = (unsigned)(uintptr_t)ldsc;
    const unsigned kdst = lds0 + OFF_K + wid * 2048, vdst = lds0 + OFF_V + wid * 2048;
    unsigned dko[2], dvo[2];
#pragma unroll
    for (int i_ = 0; i_ < 2; ++i_) { const int c_ = wid * 2 + i_;
        const int row_ = 4 * c_ + (lane >> 4), pc_ = lane & 15; dko[i_] = (unsigned)(row_ * 128 + ((pc_ ^ (row_ & 7)) * 8)) * 2u;
        const int s_ = 2 * c_ + (lane >> 5), kk_ = (s_ >> 2) * 8 + ((lane & 31) >> 2), col_ = (s_ & 3) * 32 + (lane & 3) * 8;
        const int k_ = (kk_ & ~0xC) | ((kk_ & 4) << 1) | ((kk_ & 8) >> 1); dvo[i_] = (unsigned)(k_ * 128 + col_) * 2u; }
#define DMA_TILE(t, buf) do { const char* kt_ = (const char*)Kh + (size_t)(t) * 16384; const char* vt_ = (const char*)Vh + (size_t)(t) * 16384; \
        glds16s(dko[0], kt_, kdst + (buf) * SHM); glds16s(dvo[0], vt_, vdst + (buf) * SHM); \
        glds16s(dko[1], kt_, kdst + (buf) * SHM + 1024); glds16s(dvo[1], vt_, vdst + (buf) * SHM + 1024); } while (0)
    DMA_TILE(0, 0);
    ldsp Qw = lds + OFF_Q + wid * 8192;
    { const bf16_t* Qg = T.Q + (hb + qb * 256 + wid * 32) * 128;
      bf16x8 qv[8];
#pragma unroll
      for (int i = 0; i < 8; ++i) qv[i] = *reinterpret_cast<const bf16x8*>(Qg + (i * 4 + (lane >> 4)) * 128 + (lane & 15) * 8);
#pragma unroll
      for (int i = 0; i < 8; ++i) { const int row = i * 4 + (lane >> 4); *(LAS bf16x8*)(Qw + row * 256 + (((lane & 15) * 16) ^ ((row & 7) << 4))) = qv[i]; } }
    const float negM2 = T.negM2;
    float l0 = 0.f, l1 = 0.f; f32x16 o0[4], o1[4];
#pragma unroll
    for (int d = 0; d < 4; ++d) { o0[d] = f32x16{}; o1[d] = f32x16{}; }
    const int vb0 = (int)(uintptr_t)(lds + OFF_V) + v_rd_base(lane);
    int fa[4];
#pragma unroll
    for (int d = 0; d < 4; ++d) fa[d] = r32 * 256 + ((d * 32 + hi * 16) ^ ((r32 & 7) << 4));
#define OPEN_TILE() do { asm volatile("s_waitcnt vmcnt(0) lgkmcnt(0)" ::: "memory"); __builtin_amdgcn_s_barrier(); asm volatile("" ::: "memory"); } while (0)
    OPEN_TILE(); DMA_TILE(1, 1);
    if (wid >= 4) __builtin_amdgcn_s_setprio(1);
    bf16x8 qa[4], qb_[4];
#pragma unroll
    for (int d = 0; d < 4; ++d) { qa[d] = *(const LAS bf16x8*)(Qw + fa[d]); qb_[d] = *(const LAS bf16x8*)(Qw + fa[d] + 128); }
#pragma unroll 1
    for (int t = 0; t < NT; t += 2) {
        tile<SHIFT>(lds + OFF_K, vb0, Qw, fa, qa, qb_, negM2, o0, o1, l0, l1, [&] { OPEN_TILE(); DMA_TILE((t + 2 < NT ? t + 2 : NT - 1), 0); });
        tile<SHIFT>(lds + OFF_K + SHM, vb0 + SHM, Qw, fa, qa, qb_, negM2, o0, o1, l0, l1, [&] { OPEN_TILE(); DMA_TILE((t + 3 < NT ? t + 3 : NT - 1), 1); });
    }
#undef DMA_TILE
#undef OPEN_TILE
    __builtin_amdgcn_s_setprio(0);
    asm volatile("s_waitcnt vmcnt(0) lgkmcnt(0)" ::: "memory"); __builtin_amdgcn_s_barrier(); asm volatile("" ::: "memory");
    epilogue2(o0, o1, l0, l1, b, h, qb, T, ldsc);
}
__device__ __forceinline__ void epilogue2(f32x16 (&o0)[4], f32x16 (&o1)[4], float l0, float l1, int b, int h, int qb, const Tensors& T, char* lds) {
    int tid = threadIdx.x; asm volatile("" : "+v"(tid));
    const int wid = __builtin_amdgcn_readfirstlane(tid >> 6), lane = tid & 63, r32 = lane & 31, hi = lane >> 5;
    float* wsf = (float*)(lds + OFF_WS) + wid * 64;
    { auto rr = __builtin_amdgcn_permlane32_swap(__float_as_uint(l0), __float_as_uint(l0), false, false); l0 = __uint_as_float(rr[0]) + __uint_as_float(rr[1]); }
    { auto rr = __builtin_amdgcn_permlane32_swap(__float_as_uint(l1), __float_as_uint(l1), false, false); l1 = __uint_as_float(rr[0]) + __uint_as_float(rr[1]); }
    if (hi == 0) { wsf[r32] = l0; wsf[32 + r32] = l1; }
    asm volatile("s_waitcnt lgkmcnt(0)" ::: "memory");
    float* X = (float*)(lds + wid * 16384);
    float sw[4];
#pragma unroll
    for (int d = 0; d < 4; ++d) sw[d] = T.subw[d * 32 + r32] * (1.0f - LAM_INIT);
    const float lam = T.lam;
#pragma unroll
    for (int r = 0; r < 16; ++r) {
        const int row = crow(r, hi);
        const float f1 = lam * __builtin_amdgcn_rcpf(wsf[32 + row]);
#pragma unroll
        for (int d = 0; d < 4; ++d) X[row * 128 + d * 32 + r32] = o1[d][r] * f1;
    }
    asm volatile("s_waitcnt lgkmcnt(0)" ::: "memory"); SBAR();
#pragma unroll
    for (int r = 0; r < 16; ++r) {
        const int row = crow(r, hi);
        const float f0 = __builtin_amdgcn_rcpf(wsf[row]);
        float a[4]; float ss = 0.f;
#pragma unroll
        for (int d = 0; d < 4; ++d) { a[d] = o0[d][r] * f0 - X[row * 128 + d * 32 + r32]; ss += a[d] * a[d]; }
        ss += __shfl_xor(ss, 1); ss += __shfl_xor(ss, 2); ss += __shfl_xor(ss, 4); ss += __shfl_xor(ss, 8); ss += __shfl_xor(ss, 16);
        const float rs = 1.0f / sqrtf(ss * (1.0f / 128.0f) + EPSN);
#pragma unroll
        for (int d = 0; d < 4; ++d) X[row * 128 + d * 32 + r32] = a[d] * rs * sw[d];
        SBAR();
    }
    asm volatile("s_waitcnt lgkmcnt(0)" ::: "memory");
    const long grow0 = (long)b * SEQ + qb * 256 + wid * 32;
#pragma unroll
    for (int i = 0; i < 8; ++i) {
        const int idx = i * 64 + lane, row = idx >> 4, ch = idx & 15;
        const f32x4 z0 = *(const f32x4*)(X + row * 128 + ch * 8), z1 = *(const f32x4*)(X + row * 128 + ch * 8 + 4);
        const u32x4 g = *(const u32x4*)(T.GA + (grow0 + row) * AW + h * 128 + ch * 8);
        u32x4 w;
        w.x = cvtpk(z0[0] * bf_lo(g.x), z0[1] * bf_hi(g.x)); w.y = cvtpk(z0[2] * bf_lo(g.y), z0[3] * bf_hi(g.y));
        w.z = cvtpk(z1[0] * bf_lo(g.z), z1[1] * bf_hi(g.z)); w.w = cvtpk(z1[2] * bf_lo(g.w), z1[3] * bf_hi(g.w));
        *(u32x4*)(T.MIX + (grow0 + row) * DM + h * 128 + ch * 8) = w;
    }
    __syncthreads();
}
}

template <int LO> __device__ __forceinline__ void pool_dg(const unsigned (&raw)[47], bf16_t* dst, int p0) {
    constexpr int HI = LO - 1, DGS = 1032;
    float sx = 0.f, sy = 0.f;
#pragma unroll
    for (int j = 8 - LO; j <= 8 + HI; ++j) { sx += bf_lo(raw[j]); sy += bf_hi(raw[j]); }
#pragma unroll
    for (int i = 0; i < 32; ++i) {
        const int p = p0 + i;
        const int cnt = min(p + HI, SEQ - 1) - max(p - LO, 0) + 1;
        const float rc = 1.0f / (float)cnt;
        *(unsigned*)(dst + i * DGS) = cvtpk(sx * rc - bf_lo(raw[i + 8]), sy * rc - bf_hi(raw[i + 8]));
        if (i < 31) { sx += bf_lo(raw[i + 8 + HI + 1]) - bf_lo(raw[i + 8 - LO]); sy += bf_hi(raw[i + 8 + HI + 1]) - bf_hi(raw[i + 8 - LO]); }
    }
}
__device__ __forceinline__ void pool_job(int blk, const bf16_t* U, const bf16_t* GP, const bf16_t* WPT, const float* pscale, bf16_t* MIX, char* lds) {
    int tid = threadIdx.x; asm volatile("" : "+v"(tid));
    const int wid = __builtin_amdgcn_readfirstlane(tid >> 6), lane = tid & 63, r32 = lane & 31, hi = lane >> 5;
    constexpr int DGS = 1032;
    bf16_t* dgs = (bf16_t*)lds;
    const int t0 = blk * 32, b = t0 / SEQ, p0 = t0 % SEQ;
    {
        const int ch = 2 * tid, g = wid >> 1;
        const bf16_t* base = U + (size_t)b * SEQ * AW + ch;
        unsigned raw[47];
#pragma unroll
        for (int j = 0; j < 47; ++j) { const int p = p0 - 8 + j, pc = min(max(p, 0), SEQ - 1); raw[j] = *(const unsigned*)(base + (size_t)pc * AW); }
#pragma unroll
        for (int j = 0; j < 47; ++j) { const int p = p0 - 8 + j; if (p < 0 || p >= SEQ) raw[j] = 0u; }
        if (g == 0) pool_dg<1>(raw, dgs + ch, p0); else if (g == 1) pool_dg<2>(raw, dgs + ch, p0); else if (g == 2) pool_dg<4>(raw, dgs + ch, p0); else pool_dg<8>(raw, dgs + ch, p0);
    }
    __syncthreads();
    {
        const int g = wid >> 1, nbase = (wid & 1) * 128;
        f32x16 acc[4];
#pragma unroll
        for (int nb = 0; nb < 4; ++nb) acc[nb] = f32x16{};
        const bf16_t* wp = WPT + ((size_t)(g * 256 + nbase + r32) * 256 + hi * 8);
        const bf16_t* ap = dgs + r32 * DGS + g * 256 + hi * 8;
#pragma unroll 4
        for (int ks = 0; ks < 16; ++ks) {
            const bf16x8 a = *reinterpret_cast<const bf16x8*>(ap + ks * 16);
#pragma unroll
            for (int nb = 0; nb < 4; ++nb) {
                const bf16x8 bb = *reinterpret_cast<const bf16x8*>(wp + (size_t)nb * 32 * 256 + ks * 16);
                acc[nb] = __builtin_amdgcn_mfma_f32_32x32x16_bf16(a, bb, acc[nb], 0, 0, 0);
            }
        }
        bf16_t* stg = (bf16_t*)(lds + 66048);
#pragma unroll
        for (int nb = 0; nb < 4; ++nb) {
            const int dg = g * 256 + nbase + nb * 32 + r32;
            const float ps = pscale[dg];
#pragma unroll
            for (int r = 0; r < 16; ++r) { const float y = acc[nb][r] * ps; stg[att::crow(r, hi) * 1024 + dg] = (bf16_t)(cvtpk(y, y) & 0xffffu); }
        }
    }
    __syncthreads();
    {
        const bf16_t* stg = (const bf16_t*)(lds + 66048);
#pragma unroll
        for (int i = 0; i < 8; ++i) {
            const int idx = i * 512 + tid, row = idx >> 7, ch = idx & 127;
            const u32x4 y = *(const u32x4*)(stg + row * 1024 + ch * 8);
            const size_t tok = (size_t)t0 + row;
            const u32x4 gq = *(const u32x4*)(GP + tok * AW + ch * 8);
            u32x4 w;
            w.x = cvtpk(bf_lo(y.x) * bf_lo(gq.x), bf_hi(y.x) * bf_hi(gq.x)); w.y = cvtpk(bf_lo(y.y) * bf_lo(gq.y), bf_hi(y.y) * bf_hi(gq.y));
            w.z = cvtpk(bf_lo(y.z) * bf_lo(gq.z), bf_hi(y.z) * bf_hi(gq.z)); w.w = cvtpk(bf_lo(y.w) * bf_lo(gq.w), bf_hi(y.w) * bf_hi(gq.w));
            *(u32x4*)(MIX + tok * DM + AW + ch * 8) = w;
        }
    }
    __syncthreads();
}

#define XB_TMO      128
#define XB_XCNT(j)  (256  + 64 * (j))
#define XB_XSUB(j)  (1280 + 64 * (j))
#define XB_XGEN(j)  (2304 + 64 * (j))
#define XB_TOP      3328
#define XB_TOPGEN   3392
#define XCD_BAR_WORDS 3456
#define XB_SPIN_CAP (1u << 18)

__device__ __forceinline__ unsigned xb_ld(unsigned* p)              { return __hip_atomic_load(p, __ATOMIC_RELAXED, __HIP_MEMORY_SCOPE_AGENT); }
__device__ __forceinline__ unsigned xb_add(unsigned* p, unsigned v) { return __hip_atomic_fetch_add(p, v, __ATOMIC_RELAXED, __HIP_MEMORY_SCOPE_AGENT); }
__device__ __forceinline__ unsigned xb_xcc_id() { return (unsigned)__builtin_amdgcn_s_getreg((3 << 11) | 20) & 0xFu; }
#define XB_SPIN(cond, bar) do { unsigned _sp = 0; while (cond) { __builtin_amdgcn_s_sleep(1); \
    if ((++_sp & 255u) == 0u) { if (xb_ld(&(bar)[XB_TMO])) break; if (_sp > XB_SPIN_CAP) { atomicAdd(&(bar)[XB_TMO], 1u); break; } } } } while (0)

struct XcdBarrier {
    unsigned* bar; unsigned x;
    volatile LAS unsigned* st;
};

__device__ __forceinline__ XcdBarrier xcd_barrier_post(unsigned* bar, volatile LAS unsigned* st) {
    XcdBarrier b; b.bar = bar; b.x = xb_xcc_id(); b.st = st;
    if (threadIdx.x == 0) (void)xb_add(&bar[XB_XCNT(b.x)], 1u);
    return b;
}
__device__ __forceinline__ void xcd_barrier_complete(unsigned* bar, unsigned x, unsigned& nloc, unsigned& nx) {
    const unsigned G = gridDim.x * gridDim.y * gridDim.z;
    unsigned sum, cnt, mine, sp = 0u;
    for (;;) {
        sum = 0u; cnt = 0u; mine = 0u;
#pragma unroll
        for (unsigned j = 0; j < 16; ++j) { const unsigned c = xb_ld(&bar[XB_XCNT(j)]); sum += c; cnt += (c > 0u) ? 1u : 0u; mine = (j == x) ? c : mine; }
        if (sum == G) break;
        __builtin_amdgcn_s_sleep(1);
        if ((++sp & 255u) == 0u) { if (xb_ld(&bar[XB_TMO])) break; if (sp > XB_SPIN_CAP) { atomicAdd(&bar[XB_TMO], 1u); break; } }
    }
    nloc = mine > 0u ? mine : 1u; nx = cnt > 0u ? cnt : 1u;
}

__device__ __forceinline__ void xcd_barrier(const XcdBarrier& b) {
    asm volatile("s_waitcnt vmcnt(0)" ::: "memory");
    __syncthreads();
    if (threadIdx.x == 0) {
        unsigned* bar = b.bar;
        __builtin_amdgcn_s_waitcnt(0);
        unsigned nloc = b.st[0], nx = b.st[1];
        if (nloc == 0u) { xcd_barrier_complete(bar, b.x, nloc, nx); b.st[0] = nloc; b.st[1] = nx; }
        const unsigned old = xb_add(&bar[XB_XSUB(b.x)], 1u);
        const unsigned gen = old / nloc;
        if (old + 1u == (gen + 1u) * nloc) {
            __builtin_amdgcn_fence(__ATOMIC_RELEASE, "agent");
            asm volatile("s_waitcnt vmcnt(0)" ::: "memory");
            const unsigned og = xb_add(&bar[XB_TOP], 1u);
            const unsigned tg = og / nx;
            if (og + 1u == (tg + 1u) * nx) xb_add(&bar[XB_TOPGEN], 1u);
            else XB_SPIN(xb_ld(&bar[XB_TOPGEN]) == tg, bar);
            __builtin_amdgcn_fence(__ATOMIC_ACQUIRE, "agent");
            xb_add(&bar[XB_XGEN(b.x)], 1u);
            asm volatile("s_waitcnt vmcnt(0)" ::: "memory");
        } else {
            XB_SPIN(xb_ld(&bar[XB_XGEN(b.x)]) == gen, bar);
            __builtin_amdgcn_fence(__ATOMIC_ACQUIRE, "agent");
            asm volatile("s_waitcnt vmcnt(0)" ::: "memory");
        }
    }
    __syncthreads();
}

struct TItem { const float* W; bf16_t* WT; const float* kscale; int K, N, k0, n0, drow; };
__device__ __forceinline__ void titem_load(const TItem& t, float (&tv)[32], int lane) {
#pragma unroll
    for (int i = 0; i < 32; ++i) tv[i] = t.W[(size_t)(t.k0 + 2 * i + (lane >> 5)) * t.N + t.n0 + (lane & 31)];
}
__device__ __forceinline__ void titem_finish(const TItem& t, float (&tv)[32], LAS float* scr, int lane) {
    if (t.kscale) {
#pragma unroll
        for (int i = 0; i < 32; ++i) tv[i] *= t.kscale[t.k0 + 2 * i + (lane >> 5)];
    }
#pragma unroll
    for (int i = 0; i < 32; ++i) scr[(2 * i + (lane >> 5)) * 33 + (lane & 31)] = tv[i];
    asm volatile("s_waitcnt lgkmcnt(0)" ::: "memory");
    const int c = lane & 7;
#pragma unroll
    for (int j = 0; j < 4; ++j) { const int n = (lane >> 3) + 8 * j; const LAS float* s = scr + (8 * c) * 33 + n;
        u32x4 o; o.x = cvtpk(s[0 * 33], s[1 * 33]); o.y = cvtpk(s[2 * 33], s[3 * 33]); o.z = cvtpk(s[4 * 33], s[5 * 33]); o.w = cvtpk(s[6 * 33], s[7 * 33]);
        *(u32x4*)(t.WT + (size_t)(t.drow + n) * t.K + t.k0 + 8 * c) = o; }
    asm volatile("s_waitcnt lgkmcnt(0)" ::: "memory");
}

struct Args {
    const float* in[13]; float* out; unsigned char* ws;
    double turns[8];
    int ph_lo, ph_hi;
};

__global__ void __launch_bounds__(512, 2) mega_fwd(Args args) {
    extern __shared__ __attribute__((aligned(16))) unsigned char lds[];
    const int tid = threadIdx.x, lane = tid & 63, wave = __builtin_amdgcn_readfirstlane(tid >> 6);
    const int G = gridDim.x, bx = blockIdx.x;
    const int vcu = (G % 8 == 0) ? (bx % 8) * (G / 8) + bx / 8 : bx;
    unsigned char* ws = args.ws;
    const float* x = args.in[0]; const float* norm_w = args.in[1]; const float* w_in = args.in[2]; const float* qnw = args.in[3]; const float* knw = args.in[4];
    const float* lq1 = args.in[5]; const float* lk1 = args.in[6]; const float* lq2 = args.in[7]; const float* lk2 = args.in[8];
    const float* subw = args.in[9]; const float* w_pool = args.in[10]; const float* pscale = args.in[11]; const float* w_out = args.in[12];
    float* ROPE = (float*)(ws + WS_ROPE);
    bf16_t* WPT = (bf16_t*)(ws + WS_WPT); bf16_t* WIT = (bf16_t*)(ws + WS_WIT); bf16_t* WOT = (bf16_t*)(ws + WS_WOT); bf16_t* XS = (bf16_t*)(ws + WS_XS);
    bf16_t* QB = (bf16_t*)(ws + WS_Q); bf16_t* KB = (bf16_t*)(ws + WS_K); bf16_t* VB = (bf16_t*)(ws + WS_V);
    bf16_t* GA = (bf16_t*)(ws + WS_GA); bf16_t* UB = (bf16_t*)(ws + WS_U); bf16_t* GP = (bf16_t*)(ws + WS_GP); bf16_t* MIX = (bf16_t*)(ws + WS_MIX);
    const int lo = args.ph_lo, hi = args.ph_hi;
    volatile LAS unsigned* MISC = (volatile LAS unsigned*)((LAS unsigned char*)lds + 133120);
    if (tid < 2) MISC[tid] = 0u;
    __syncthreads();
    XcdBarrier bar = xcd_barrier_post((unsigned*)(ws + WS_CTL), MISC);
#ifdef ONLY_PHASE
#define IN(k) ((k) == ONLY_PHASE && lo <= (k) && (k) < hi)
#else
#define IN(k) (lo <= (k) && (k) < hi)
#endif
#define SEAM(k) do { if (IN(k) && IN((k) + 1)) { if ((k) == 0) cg::this_grid().sync(); else xcd_barrier(bar); } } while (0)

    if (IN(0)) {
        LAS float* scr = (LAS float*)((LAS unsigned char*)lds + wave * 16384);
        const int gw = vcu * 8 + wave, NGW = G * 8;
        constexpr int I_IN = (DM / 64) * (NIN / 32), I_OUT = (DM / 64) * (DM / 32), I_P = 4 * (256 / 64) * (256 / 32);
        auto decode = [&](int it) -> TItem {
            TItem t; int r = it;
            if (r < I_IN) { const int nblk = NIN / 32, kb = r / nblk, nb = r % nblk, n0 = nb * 32, a = n0 & 255;
                t.W = w_in; t.WT = WIT; t.kscale = norm_w; t.K = DM; t.N = NIN; t.k0 = kb * 64; t.n0 = n0; t.drow = (n0 & ~255) + ((a >> 5) & 1) * 128 + (a >> 6) * 32; return t; }
            r -= I_IN;
            if (r < I_OUT) { const int nblk = DM / 32, kb = r / nblk, nb = r % nblk;
                t.W = w_out; t.WT = WOT; t.kscale = nullptr; t.K = DM; t.N = DM; t.k0 = kb * 64; t.n0 = nb * 32; t.drow = nb * 32; return t; }
            r -= I_OUT;
            { const int g = r / 32, rr = r % 32, kb = rr / 8, nb = rr % 8;
              t.W = w_pool + (size_t)g * 65536; t.WT = WPT + (size_t)g * 65536; t.kscale = nullptr; t.K = 256; t.N = 256; t.k0 = kb * 64; t.n0 = nb * 32; t.drow = nb * 32; return t; }
        };
        constexpr int NIT = I_IN + I_OUT + I_P;
        for (int it = gw; it < NIT; it += 2 * NGW) {
            const int it1 = it + NGW; const bool two = it1 < NIT;
            const TItem ta = decode(it), tb = decode(two ? it1 : it);
            float va[32], vb[32];
            titem_load(ta, va, lane);
            if (two) titem_load(tb, vb, lane);
            titem_finish(ta, va, scr, lane);
            if (two) titem_finish(tb, vb, scr, lane);
        }
        for (int m = gw; m < MTOK; m += 2 * NGW) {
            const int m2 = (m + NGW < MTOK) ? m + NGW : m;
            const f32x4* xr0 = (const f32x4*)(x + (size_t)m * DM) + lane; const f32x4* xr1 = (const f32x4*)(x + (size_t)m2 * DM) + lane;
            f32x4 v[8], w2[8]; float s0 = 0.f, s1 = 0.f;
#pragma unroll
            for (int j = 0; j < 8; ++j) { v[j] = xr0[64 * j]; w2[j] = xr1[64 * j]; }
#pragma unroll
            for (int j = 0; j < 8; ++j) { s0 += (v[j].x * v[j].x + v[j].y * v[j].y) + (v[j].z * v[j].z + v[j].w * v[j].w); s1 += (w2[j].x * w2[j].x + w2[j].y * w2[j].y) + (w2[j].z * w2[j].z + w2[j].w * w2[j].w); }
            const float r0 = 1.0f / sqrtf(wave_sum(s0) * (1.0f / DM) + EPSN), r1 = 1.0f / sqrtf(wave_sum(s1) * (1.0f / DM) + EPSN);
            u32x2* o0 = (u32x2*)(XS + (size_t)m * DM) + lane; u32x2* o1 = (u32x2*)(XS + (size_t)m2 * DM) + lane;
#pragma unroll
            for (int j = 0; j < 8; ++j) { u32x2 w; w.x = cvtpk(v[j].x * r0, v[j].y * r0); w.y = cvtpk(v[j].z * r0, v[j].w * r0); o0[64 * j] = w;
                                          u32x2 y; y.x = cvtpk(w2[j].x * r1, w2[j].y * r1); y.y = cvtpk(w2[j].z * r1, w2[j].w * r1); o1[64 * j] = y; }
        }
        for (int e = (vcu * 512 + tid); e < SEQ * 8; e += G * 512) {
            const int pos = e >> 3, i = e & 7;
            const double t = (double)pos * args.turns[i];
            const float fr = (float)(t - floor(t));
            ROPE[pos * 16 + i] = __builtin_amdgcn_cosf(fr);
            ROPE[pos * 16 + 8 + i] = __builtin_amdgcn_sinf(fr);
        }
    }
    SEAM(0);

    if (IN(1)) {
        pg8::Gemm g{XS, WIT, MTOK, NIN, DM}; pg8::StaticOrder S; S.init(MTOK, NIN, G, bx);
        EpiProj E{QB, KB, VB, GA, UB, GP, qnw, knw, ROPE, 0.125f * LOG2E};
        pg8::gemm_phase<EpiProj, pg8::StaticOrder, true, true>((LAS unsigned char*)lds, g, S, E);
    }
    SEAM(1);

    if (IN(2)) {
        const float d1 = wave_sum(lq1[lane] * lk1[lane]), d2 = wave_sum(lq2[lane] * lk2[lane]);
        const float lam = __expf(d1) - __expf(d2) + LAM_INIT;
        const float mq = wave_max(fabsf(qnw[lane])), mk = wave_max(fabsf(knw[lane]));
        const float M2 = 8.0f * mq * mk * LOG2E * 1.02f;
        const float lam_s = __uint_as_float(__builtin_amdgcn_readfirstlane(__float_as_uint(lam)));
        const float nm2_s = __uint_as_float(__builtin_amdgcn_readfirstlane(__float_as_uint(-M2)));
        att::Tensors T{QB, KB, VB, GA, MIX, subw, lam_s, nm2_s};
        for (int u = vcu; u < 256; u += G) { const int bh = u >> 4, qb = u & 15;
            if (nm2_s < -40.0f) att2::unit<true>(bh >> 3, bh & 7, qb, T, (char*)lds); else att2::unit<false>(bh >> 3, bh & 7, qb, T, (char*)lds); }
        for (int blk = vcu; blk < MTOK / 32; blk += G) pool_job(blk, UB, GP, WPT, pscale, MIX, (char*)lds);
    }
    SEAM(2);

    if (IN(3)) {
        pg8::Gemm g{MIX, WOT, MTOK, DM, DM}; pg8::StaticOrder S; S.init(MTOK, DM, G, bx);
        EpiOut E{x, args.out};
        pg8::gemm_phase<EpiOut, pg8::StaticOrder, true, true>((LAS unsigned char*)lds, g, S, E);
    }
#undef IN
#undef SEAM
}

constexpr int LDS_BYTES = 135168;
extern "C" void kernel_launch(void* const* d_in, const int* in_sizes, int n_in, void* d_out, int out_size, void* d_ws, size_t ws_size, hipStream_t stream) {
    static int grid = 0;
    if (grid == 0) {
        if (n_in != 13 || in_sizes[0] != MTOK * DM || out_size != MTOK * DM || ws_size < WS_END) { fprintf(stderr, "kernel_launch: unexpected shapes\n"); grid = -1; return; }
        int dev = 0, cus = 0, per_cu = 0;
        (void)hipGetDevice(&dev);
        (void)hipDeviceGetAttribute(&cus, hipDeviceAttributeMultiprocessorCount, dev);
        if (hipFuncSetAttribute((const void*)mega_fwd, hipFuncAttributeMaxDynamicSharedMemorySize, LDS_BYTES) != hipSuccess) { fprintf(stderr, "kernel_launch: hipFuncSetAttribute failed\n"); grid = -1; return; }
        if (hipOccupancyMaxActiveBlocksPerMultiprocessor(&per_cu, (const void*)mega_fwd, 512, LDS_BYTES) != hipSuccess || per_cu < 1) { fprintf(stderr, "kernel_launch: occupancy query failed (%d)\n", per_cu); per_cu = 1; }
        (void)hipGetLastError();
        grid = cus * (per_cu > 1 ? 1 : per_cu);
        if (grid > 256) grid = 256;
    }
    if (grid < 0) return;
    Args a{};
    for (int i = 0; i < 13; ++i) a.in[i] = (const float*)d_in[i];
    a.out = (float*)d_out; a.ws = (unsigned char*)d_ws;
    for (int i = 0; i < 8; ++i) a.turns[i] = std::pow(500000.0, -(double)(2 * i) / 16.0) / 6.283185307179586476925;
    constexpr int NL = MK_N_LAUNCHES;
    (void)hipMemsetAsync((char*)d_ws + WS_CTL, 0, CTL_BYTES, stream);
    if (NL == 1) {
        a.ph_lo = 0; a.ph_hi = 4;
        void* kargs[] = {&a};
        hipError_t e = hipLaunchCooperativeKernel((const void*)mega_fwd, dim3(grid), dim3(512), kargs, LDS_BYTES, stream);
        if (e != hipSuccess) fprintf(stderr, "cooperative launch failed: %s (grid %d)\n", hipGetErrorString(e), grid);
        if (PROBE_EXTRA_PHASE >= 0) { a.ph_lo = PROBE_EXTRA_PHASE; a.ph_hi = PROBE_EXTRA_PHASE + 1; hipLaunchKernelGGL(mega_fwd, dim3(grid), dim3(512), LDS_BYTES, stream, a); }
    } else {
        for (int p = 0; p < 4; ++p) { a.ph_lo = p; a.ph_hi = p + 1; hipLaunchKernelGGL(mega_fwd, dim3(grid), dim3(512), LDS_BYTES, stream, a); }
    }
}
```

```cpp
#include <hip/hip_runtime.h>
#include <hip/hip_cooperative_groups.h>
#include <hip/hip_bf16.h>
#include <cstdio>
#include <cstdint>
#include <cmath>
namespace cg = cooperative_groups;

#ifndef PROBE_EXTRA_PHASE
#define PROBE_EXTRA_PHASE -1
#endif
#ifndef MK_N_LAUNCHES
#define MK_N_LAUNCHES 1
#endif

namespace pg8 {
#define PG8_LAS __attribute__((address_space(3)))
typedef unsigned short bf16_t;
typedef short bf16x8 __attribute__((ext_vector_type(8)));
typedef float f32x4 __attribute__((ext_vector_type(4)));
typedef unsigned u32x4 __attribute__((ext_vector_type(4)));
constexpr int BM = 256, BK = 64, HALF = 128, HTB = HALF * BK * 2  , STAGE_BYTES = 8 * HTB, NXCD = 8, WGM = 8;

__host__ __device__ __forceinline__ int lds_byte(int r, int c) { const int st = (r >> 4) * 2 + (c >> 5), rr = r & 15, cc = c & 31, ob = rr * 64 + cc * 2; return st * 1024 + (ob ^ (((ob >> 9) & 1) << 5)); }
__host__ __device__ __forceinline__ void stage_rc(int b, int& R, int& C) { const int st = b / 1024, sb = b % 1024, swz = sb ^ (((sb >> 9) & 1) << 5); R = (st >> 1) * 16 + swz / 64; C = (st & 1) * 32 + (swz % 64) / 2; }
__host__ __device__ __forceinline__ int perm32(int rho) { const int n = rho >> 4, i = rho & 15; return 8 * (i >> 2) + 4 * n + (i & 3); }

struct Unit { int pm, pn; };
struct Gemm { const bf16_t* A; const bf16_t* Bt; int M, N, K, ld; };

struct StaticOrder {
    int nM, nN, nwg, G, c;
    __host__ __device__ void init(int M, int N, int G_, int c_) { nM = M / BM; nN = N / BM; nwg = nM * nN; G = G_; c = c_; }
    __host__ __device__ bool next(int i, Unit& u) const {
        const long L = (long)i * G + c; if (L >= nwg) return false;
        int wgid = (int)L; { const int q = nwg / NXCD, r = nwg % NXCD, xcd = wgid % NXCD, off = wgid / NXCD; wgid = (xcd < r ? xcd * (q + 1) : r * (q + 1) + (xcd - r) * q) + off; }
        const int nig = WGM * nN, gid = wgid / nig, fm = gid * WGM, gsz = (nM - fm) < WGM ? (nM - fm) : WGM;
        u.pm = fm + ((wgid % nig) % gsz); u.pn = (wgid % nig) / gsz; return true;
    }
    __device__ __forceinline__ void a_ready(const Unit&) const {}
    __device__ __forceinline__ void done(const Unit&) const {}
};

__device__ __forceinline__ unsigned cvt_pk_bf16(float lo, float hi) { unsigned r; asm volatile("v_cvt_pk_bf16_f32 %0, %1, %2" : "=v"(r) : "v"(lo), "v"(hi)); return r; }
template <class Epi, class Sched, bool ALIGN_EPI = false, bool SP2 = false>
__device__ __forceinline__ void gemm_phase(PG8_LAS unsigned char* lds, const Gemm g, const Sched& S, const Epi& E) {
    int tid = threadIdx.x; asm volatile("" : "+v"(tid));
    const int wid = __builtin_amdgcn_readfirstlane(tid >> 6), lane = tid & 63, wr = wid >> 2, wc = wid & 3, fr = lane & 15, fq = lane >> 4;
    const int K = g.K, nt = K / BK;
    unsigned voffA[2], voffB[2];
#pragma unroll
    for (int i = 0; i < 2; ++i) { int R, C; stage_rc(tid * 16 + i * 8192, R, C); const int Rb = Epi::PERM ? ((R & ~31) + perm32(R & 31)) : R;
        voffA[i] = (unsigned)(R * g.ld + C) * 2u; voffB[i] = (unsigned)(Rb * g.ld + C) * 2u; }
    const size_t kstep = (size_t)(BK * 2);
    const size_t hstep = (size_t)HALF * g.ld * 2;
    const size_t tstep = 2 * hstep;
    const unsigned ldsw = (unsigned)wid * 1024u;
    const int aoff = lds_byte(wr * 64 + fr, fq * 8), boff = lds_byte(wc * 32 + fr, fq * 8);
#define PG8_SA(b, h) (((b) * 2 + (h)) * HTB)
#define PG8_SB(b, h) ((4 + (b) * 2 + (h)) * HTB)
#define PG8_STAGE(bufoff, gbase, voff) do { _Pragma("unroll") for (int _i = 0; _i < 2; ++_i) \
        __builtin_amdgcn_global_load_lds((const unsigned*)((const char*)(gbase) + (voff)[_i]), (PG8_LAS unsigned*)(lds + (bufoff) + ldsw + _i * 8192), 16, 0, 0); } while (0)
#define PG8_LDA(dst, b, h) do { _Pragma("unroll") for (int m = 0; m < 4; ++m) _Pragma("unroll") for (int k = 0; k < 2; ++k) dst[m][k] = *(const PG8_LAS bf16x8*)(lds + PG8_SA(b, h) + aoff + m * 2048 + k * 1024); } while (0)
#define PG8_LDB(dst, b, h) do { _Pragma("unroll") for (int n = 0; n < 2; ++n) _Pragma("unroll") for (int k = 0; k < 2; ++k) dst[n][k] = *(const PG8_LAS bf16x8*)(lds + PG8_SB(b, h) + boff + n * 2048 + k * 1024); } while (0)
#define PG8_MMA(ai, bj, At, Bt) do { __builtin_amdgcn_s_setprio(1); _Pragma("unroll") for (int m = 0; m < 4; ++m) _Pragma("unroll") for (int n = 0; n < 2; ++n) _Pragma("unroll") for (int k = 0; k < 2; ++k) \
        acc[ai][bj][m][n] = __builtin_amdgcn_mfma_f32_16x16x32_bf16(Bt[n][k], At[m][k], acc[ai][bj][m][n], 0, 0, 0); __builtin_amdgcn_s_setprio(0); } while (0)
#define PG8_WAIT_V(n) asm volatile("s_waitcnt vmcnt(" #n ")" ::: "memory")
#define PG8_WAIT_L(n) asm volatile("s_waitcnt lgkmcnt(" #n ")" ::: "memory")
#define PG8_BAR __builtin_amdgcn_s_barrier()
#define PG8_SCHED __builtin_amdgcn_sched_barrier(0)
    Unit cur, nxt; int ui = 0;
    if (!S.next(0, cur)) return;
    f32x4 acc[2][2][4][2];
    if constexpr (Epi::INIT) E.init(acc, cur, wr, wc, fr, fq);
    else {
#pragma unroll
    for (int a = 0; a < 2; ++a)
#pragma unroll
        for (int b = 0; b < 2; ++b)
#pragma unroll
            for (int m = 0; m < 4; ++m)
#pragma unroll
                for (int n = 0; n < 2; ++n) acc[a][b][m][n] = (f32x4){0.f, 0.f, 0.f, 0.f};
    }
    bf16x8 At[4][2], B0[2][2], B1[2][2];
    const char* cA = (const char*)g.A + (size_t)cur.pm * tstep; const char* cB = (const char*)g.Bt + (size_t)cur.pn * tstep;
    S.a_ready(cur);
    if constexpr (SP2) {
        PG8_STAGE(PG8_SB(0, 0), cB, voffB); PG8_STAGE(PG8_SB(0, 1), cB + hstep, voffB); PG8_STAGE(PG8_SA(0, 0), cA, voffA); PG8_STAGE(PG8_SA(0, 1), cA + hstep, voffA);
        if (wr == 1) PG8_BAR;
        PG8_WAIT_V(2); PG8_BAR;
        PG8_STAGE(PG8_SB(1, 0), cB + kstep, voffB); PG8_STAGE(PG8_SA(1, 0), cA + kstep, voffA); PG8_STAGE(PG8_SB(1, 1), cB + hstep + kstep, voffB);
        PG8_WAIT_V(6); PG8_BAR;
    } else {
        PG8_STAGE(PG8_SB(0, 0), cB, voffB); PG8_STAGE(PG8_SA(0, 0), cA, voffA); PG8_STAGE(PG8_SB(0, 1), cB + hstep, voffB); PG8_STAGE(PG8_SA(0, 1), cA + hstep, voffA);
        if (wr == 1) PG8_BAR;
        PG8_WAIT_V(4); PG8_BAR;
        PG8_STAGE(PG8_SB(1, 0), cB + kstep, voffB); PG8_STAGE(PG8_SA(1, 0), cA + kstep, voffA); PG8_STAGE(PG8_SB(1, 1), cB + hstep + kstep, voffB);
        PG8_WAIT_V(6); PG8_BAR;
    }
    for (;;) {
        const bool has_next = S.next(ui + 1, nxt);
        const char* nA = has_next ? (const char*)g.A + (size_t)nxt.pm * tstep : cA; const char* nB = has_next ? (const char*)g.Bt + (size_t)nxt.pn * tstep : cB;
        for (int t = 0; t < nt; t += 2) {
            const bool last = (t == nt - 2);
            const char* a1 = cA + (size_t)(t + 1) * kstep;
            const char* a2 = last ? nA : cA + (size_t)(t + 2) * kstep; const char* b2 = last ? nB : cB + (size_t)(t + 2) * kstep;
            const char* a3 = a2 + kstep; const char* b3 = b2 + kstep;
            if (last && has_next) S.a_ready(nxt);
            if constexpr (SP2) {
            PG8_LDB(B0, 0, 0); PG8_LDB(B1, 0, 1); PG8_SCHED; PG8_LDA(At, 0, 0); PG8_STAGE(PG8_SA(1, 1), a1 + hstep, voffA);
            PG8_WAIT_V(8); PG8_WAIT_L(0); PG8_BAR; PG8_MMA(0, 0, At, B0); PG8_MMA(0, 1, At, B1); PG8_BAR; PG8_SCHED;
            PG8_LDA(At, 0, 1); PG8_STAGE(PG8_SB(0, 0), b2, voffB); PG8_STAGE(PG8_SB(0, 1), b2 + hstep, voffB); PG8_STAGE(PG8_SA(0, 0), a2, voffA);
            PG8_WAIT_V(8); PG8_WAIT_L(0); PG8_BAR; PG8_MMA(1, 0, At, B0); PG8_MMA(1, 1, At, B1); PG8_BAR; PG8_SCHED;
            PG8_LDB(B0, 1, 0); PG8_LDB(B1, 1, 1); PG8_SCHED; PG8_LDA(At, 1, 0); PG8_STAGE(PG8_SA(0, 1), a2 + hstep, voffA);
            PG8_WAIT_V(8); PG8_WAIT_L(0); PG8_BAR; PG8_MMA(0, 0, At, B0); PG8_MMA(0, 1, At, B1); PG8_BAR; PG8_SCHED;
            PG8_LDA(At, 1, 1); PG8_STAGE(PG8_SB(1, 0), b3, voffB); PG8_STAGE(PG8_SB(1, 1), b3 + hstep, voffB); PG8_STAGE(PG8_SA(1, 0), a3, voffA);
            PG8_WAIT_V(8); PG8_WAIT_L(0); PG8_BAR; PG8_MMA(1, 0, At, B0); PG8_MMA(1, 1, At, B1); PG8_BAR; PG8_SCHED;
            } else {
            PG8_LDB(B0, 0, 0); PG8_SCHED; PG8_LDA(At, 0, 0); PG8_STAGE(PG8_SA(1, 1), a1 + hstep, voffA);
            PG8_WAIT_L(8); PG8_BAR; PG8_WAIT_L(0); PG8_MMA(0, 0, At, B0); PG8_BAR; PG8_SCHED;
            PG8_LDB(B1, 0, 1); PG8_STAGE(PG8_SB(0, 0), b2, voffB);
            PG8_BAR; PG8_WAIT_L(0); PG8_MMA(0, 1, At, B1); PG8_BAR;
            PG8_LDA(At, 0, 1); PG8_STAGE(PG8_SA(0, 0), a2, voffA);
            PG8_BAR; PG8_WAIT_L(0); PG8_MMA(1, 0, At, B0); PG8_BAR; PG8_SCHED;
            PG8_STAGE(PG8_SB(0, 1), b2 + hstep, voffB);
            PG8_WAIT_V(6); PG8_BAR; PG8_MMA(1, 1, At, B1); PG8_BAR;
            PG8_LDB(B0, 1, 0); PG8_SCHED; PG8_LDA(At, 1, 0); PG8_STAGE(PG8_SA(0, 1), a2 + hstep, voffA);
            PG8_WAIT_L(8); PG8_BAR; PG8_WAIT_L(0); PG8_MMA(0, 0, At, B0); PG8_BAR; PG8_SCHED;
            PG8_LDB(B1, 1, 1); PG8_STAGE(PG8_SB(1, 0), b3, voffB);
            PG8_BAR; PG8_WAIT_L(0); PG8_MMA(0, 1, At, B1); PG8_BAR;
            PG8_LDA(At, 1, 1); PG8_STAGE(PG8_SA(1, 0), a3, voffA);
            PG8_BAR; PG8_WAIT_L(0); PG8_MMA(1, 0, At, B0); PG8_BAR; PG8_SCHED;
            PG8_STAGE(PG8_SB(1, 1), b3 + hstep, voffB);
            PG8_WAIT_V(6); PG8_BAR; PG8_MMA(1, 1, At, B1); PG8_BAR;
            }
        }
        if constexpr (ALIGN_EPI) { if (wr == 0) PG8_BAR; }
        if constexpr (!Epi::AFTER_DRAIN) { E(acc, cur, wr, wc, fr, fq); S.done(cur); }
        if (!has_next) break;
        if constexpr (Epi::INIT) E.init(acc, nxt, wr, wc, fr, fq);
        else {
#pragma unroll
        for (int a = 0; a < 2; ++a)
#pragma unroll
            for (int b = 0; b < 2; ++b)
#pragma unroll
                for (int m = 0; m < 4; ++m)
#pragma unroll
                    for (int n = 0; n < 2; ++n) acc[a][b][m][n] = (f32x4){0.f, 0.f, 0.f, 0.f};
        }
        cur = nxt; cA = nA; cB = nB; ++ui;
        if constexpr (ALIGN_EPI) { if (wr == 1) PG8_BAR; }
    }
    PG8_WAIT_V(0);
    if constexpr (!ALIGN_EPI) { if (wr == 0) PG8_BAR; }
    PG8_BAR;
    if constexpr (Epi::AFTER_DRAIN) { E.fused(acc, cur, wr, wc, fr, fq, lds, wid, lane); S.done(cur); }
#undef PG8_SA
#undef PG8_SB
#undef PG8_STAGE
#undef PG8_LDA
#undef PG8_LDB
#undef PG8_MMA
#undef PG8_WAIT_V
#undef PG8_WAIT_L
#undef PG8_BAR
#undef PG8_SCHED
}
}

constexpr int BATCH = 2, SEQ = 4096, DM = 2048, MTOK = BATCH * SEQ;
constexpr int AW = 1024, PW = 1024, NIN = 6144, HD = 64, NH = 8;
constexpr float EPSN = 1e-6f;
constexpr float LAM_INIT = 0.2f;
constexpr float LOG2E = 1.4426950408889634f;

constexpr size_t MiB = 1u << 20;
constexpr size_t WS_ROPE = 0;
constexpr size_t WS_CTL = 512 * 1024, CTL_BYTES = 16384;
constexpr size_t WS_WPT = 1 * MiB;
constexpr int LDP = DM + 64;
constexpr size_t WS_WIT = 2 * MiB;
constexpr size_t WS_WOT = 27 * MiB;
constexpr size_t WS_XS = 36 * MiB;
constexpr size_t WS_Q = 70 * MiB, WS_K = 86 * MiB, WS_V = 102 * MiB, WS_GA = 118 * MiB, WS_U = 134 * MiB, WS_GP = 150 * MiB;
constexpr size_t WS_MIX = 166 * MiB;
constexpr size_t WS_END = 200 * MiB;
static_assert(WS_WIT + (size_t)6144 * LDP * 2 <= WS_WOT && WS_WOT + (size_t)2048 * LDP * 2 <= WS_XS && WS_XS + (size_t)8192 * LDP * 2 <= WS_Q && WS_MIX + (size_t)8192 * LDP * 2 <= WS_END, "d_ws map");

#define LAS __attribute__((address_space(3)))
typedef unsigned short bf16_t;
typedef float f32x4 __attribute__((ext_vector_type(4)));
typedef float f32x2 __attribute__((ext_vector_type(2)));
typedef unsigned u32x4 __attribute__((ext_vector_type(4)));
typedef unsigned u32x2 __attribute__((ext_vector_type(2)));
typedef short bf16x8 __attribute__((ext_vector_type(8)));
typedef short s16x4 __attribute__((ext_vector_type(4)));
typedef float f32x16 __attribute__((ext_vector_type(16)));

typedef __bf16 bf16x2_cv __attribute__((ext_vector_type(2)));
__device__ __forceinline__ unsigned cvtpk(float lo, float hi) { f32x2 v = {lo, hi}; bf16x2_cv b = __builtin_convertvector(v, bf16x2_cv); return __builtin_bit_cast(unsigned, b); }
__device__ __forceinline__ float bf_lo(unsigned w) { return __uint_as_float(w << 16); }
__device__ __forceinline__ float bf_hi(unsigned w) { return __uint_as_float(w & 0xffff0000u); }
__device__ __forceinline__ float silu_f(float x) { return x * __builtin_amdgcn_rcpf(1.0f + __builtin_amdgcn_exp2f(-x * LOG2E)); }
__device__ __forceinline__ float wave_sum(float v) {
#pragma unroll
    for (int o = 1; o < 64; o <<= 1) v += __shfl_xor(v, o);
    return v;
}
__device__ __forceinline__ float wave_max(float v) {
#pragma unroll
    for (int o = 1; o < 64; o <<= 1) v = fmaxf(v, __shfl_xor(v, o));
    return v;
}

struct EpiProj {
    static constexpr bool PERM = true, AFTER_DRAIN = false, INIT = false;
    bf16_t *Q, *K, *V, *GA, *U, *GP; const float *qw, *kw; const float* rope; float qscale;
    __device__ __forceinline__ void operator()(const f32x4 (&acc)[2][2][4][2], const pg8::Unit& u, int wr, int wc, int fr, int fq) const {
        const int type = u.pn >> 2;
        const int col0 = (u.pn & 3) * 256 + wc * 64 + fq * 8;
        const int row0 = u.pm * 256 + wr * 64 + fr;
        if (type <= 1) {
            const float* wsrc = (type == 0 ? qw : kw) + fq * 8;
            const f32x4 w00 = *(const f32x4*)(wsrc), w01 = *(const f32x4*)(wsrc + 4), w10 = *(const f32x4*)(wsrc + 32), w11 = *(const f32x4*)(wsrc + 36);
            bf16_t* dsth = (type == 0 ? Q : K) + (size_t)(((u.pm * 256) >> 12) * NH + (col0 >> 7)) * SEQ * 128 + (col0 & 127);
            const float sc = (type == 0) ? qscale : 1.0f;
            const float sgn = (fq == 0) ? -1.0f : 1.0f;
#pragma unroll
            for (int ai = 0; ai < 2; ++ai) {
                f32x4 rc[4][4];
#pragma unroll
                for (int m = 0; m < 4; ++m) { const float* rp = rope + ((row0 + ai * 128 + m * 16) & (SEQ - 1)) * 16;
#pragma unroll
                    for (int q = 0; q < 4; ++q) rc[m][q] = (fq < 2) ? *(const f32x4*)(rp + 4 * q) : (f32x4){0.f, 0.f, 0.f, 0.f}; }
                asm volatile("" ::: "memory");
#pragma unroll
                for (int m = 0; m < 4; ++m) {
                    const int row = row0 + ai * 128 + m * 16, pos = row & (SEQ - 1);
                    f32x4 v00 = acc[ai][0][m][0], v01 = acc[ai][0][m][1], v10 = acc[ai][1][m][0], v11 = acc[ai][1][m][1];
                    float ss = (v00[0] * v00[0] + v00[1] * v00[1]) + (v00[2] * v00[2] + v00[3] * v00[3]);
                    ss += (v01[0] * v01[0] + v01[1] * v01[1]) + (v01[2] * v01[2] + v01[3] * v01[3]);
                    ss += (v10[0] * v10[0] + v10[1] * v10[1]) + (v10[2] * v10[2] + v10[3] * v10[3]);
                    ss += (v11[0] * v11[0] + v11[1] * v11[1]) + (v11[2] * v11[2] + v11[3] * v11[3]);
                    ss += __shfl_xor(ss, 16); ss += __shfl_xor(ss, 32);
                    const float rs = 1.0f / sqrtf(ss * (1.0f / 64.0f) + EPSN);
                    v00 = v00 * rs * w00; v01 = v01 * rs * w01; v10 = v10 * rs * w10; v11 = v11 * rs * w11;
                    f32x4 o00, o01;
#pragma unroll
                    for (int i = 0; i < 4; ++i) { o00[i] = __shfl_xor(v00[i], 16); o01[i] = __shfl_xor(v01[i], 16); }
                    if (fq < 2) {
                        const f32x4 c0 = rc[m][0], c1 = rc[m][1], s0 = rc[m][2], s1 = rc[m][3];
                        v00 = v00 * c0 + (o00 * s0) * sgn; v01 = v01 * c1 + (o01 * s1) * sgn;
                    }
                    v00 = v00 * sc; v01 = v01 * sc; v10 = v10 * sc; v11 = v11 * sc;
                    u32x4 a, b;
                    a.x = cvtpk(v00[0], v00[1]); a.y = cvtpk(v00[2], v00[3]); a.z = cvtpk(v01[0], v01[1]); a.w = cvtpk(v01[2], v01[3]);
                    b.x = cvtpk(v10[0], v10[1]); b.y = cvtpk(v10[2], v10[3]); b.z = cvtpk(v11[0], v11[1]); b.w = cvtpk(v11[2], v11[3]);
                    bf16_t* rowp = dsth + (size_t)pos * 128;
                    *(u32x4*)(rowp) = a; *(u32x4*)(rowp + 32) = b;
                }
                asm volatile("" ::: "memory");
            }
        } else {
            bf16_t* dst = (type == 2) ? V : (type == 3) ? GA : (type == 4) ? U : GP;
            const bool act = (type == 3) || (type == 5);
            const bool hm = (type == 2);
            const int rstride = hm ? 128 : AW, rmask = hm ? (SEQ - 1) : 0x7fffffff;
            dst += hm ? (size_t)(((u.pm * 256) >> 12) * NH + (col0 >> 7)) * SEQ * 128 + (col0 & 127) : (size_t)col0;
#pragma unroll
            for (int ai = 0; ai < 2; ++ai)
#pragma unroll
                for (int m = 0; m < 4; ++m) {
                    const int row = row0 + ai * 128 + m * 16;
                    bf16_t* rowp = dst + (size_t)(row & rmask) * rstride;
#pragma unroll
                    for (int bj = 0; bj < 2; ++bj) {
                        f32x4 v0 = acc[ai][bj][m][0], v1 = acc[ai][bj][m][1];
                        if (act) {
#pragma unroll
                            for (int i = 0; i < 4; ++i) { v0[i] = silu_f(v0[i]); v1[i] = silu_f(v1[i]); }
                        }
                        u32x4 a; a.x = cvtpk(v0[0], v0[1]); a.y = cvtpk(v0[2], v0[3]); a.z = cvtpk(v1[0], v1[1]); a.w = cvtpk(v1[2], v1[3]);
                        *(u32x4*)(rowp + bj * 32) = a;
                    }
                }
        }
    }
};
struct EpiOut {
    static constexpr bool PERM = true, AFTER_DRAIN = false, INIT = true;
    const float* x; float* out;
    __device__ __forceinline__ void init(f32x4 (&acc)[2][2][4][2], const pg8::Unit& u, int wr, int wc, int fr, int fq) const {
        const int row0 = u.pm * 256 + wr * 64 + fr, col0 = u.pn * 256 + wc * 32 + fq * 8;
#pragma unroll
        for (int ai = 0; ai < 2; ++ai)
#pragma unroll
            for (int m = 0; m < 4; ++m) { const size_t off = (size_t)(row0 + ai * 128 + m * 16) * DM + col0;
#pragma unroll
                for (int bj = 0; bj < 2; ++bj) { acc[ai][bj][m][0] = *(const f32x4*)(x + off + bj * 128); acc[ai][bj][m][1] = *(const f32x4*)(x + off + bj * 128 + 4); } }
    }
    __device__ __forceinline__ void operator()(const f32x4 (&acc)[2][2][4][2], const pg8::Unit& u, int wr, int wc, int fr, int fq) const {
        const int row0 = u.pm * 256 + wr * 64 + fr, col0 = u.pn * 256 + wc * 32 + fq * 8;
#pragma unroll
        for (int ai = 0; ai < 2; ++ai)
#pragma unroll
            for (int m = 0; m < 4; ++m) { const size_t off = (size_t)(row0 + ai * 128 + m * 16) * DM + col0;
#pragma unroll
                for (int bj = 0; bj < 2; ++bj) { *(f32x4*)(out + off + bj * 128) = acc[ai][bj][m][0]; *(f32x4*)(out + off + bj * 128 + 4) = acc[ai][bj][m][1]; } }
    }
};

namespace att {
constexpr int KVBLK = 64, NT = SEQ / KVBLK, LD = 128;
constexpr int SHM_V = KVBLK * 128 * 2, SHM_K = KVBLK * 128 * 2;
constexpr int OFF_V = 0, OFF_K = 2 * SHM_V, OFF_WS = 2 * SHM_V + 2 * SHM_K;
#define KSWZ(row, colB) ((row) * 256 + ((colB) ^ (((row) & 7) << 4)))
#define SBAR() __builtin_amdgcn_sched_barrier(0)
__device__ __forceinline__ int crow(int r, int hi) { return (r & 3) + 8 * (r >> 2) + 4 * hi; }
__device__ __forceinline__ int v_st(int k, int c) { const int kk = (k & ~0xC) | ((k & 4) << 1) | ((k & 8) >> 1); return ((kk >> 3) * 4 + (c >> 5)) * 512 + ((kk & 7) * 32 + (c & 31)) * 2; }
__device__ __forceinline__ int v_rd_base(int lane) { return ((lane & 3) << 3) | (((lane >> 2) & 3) << 6) | (((lane >> 4) & 1) << 5) | (((lane >> 5) & 1) << 8); }
constexpr int v_rd_off(int d0, int ks, int half) { return d0 * 512 + ks * 4096 + half * 2048; }
template <int OFF> __device__ __forceinline__ s16x4 tr_read(int vb) {
    s16x4 r; asm volatile("ds_read_b64_tr_b16 %0, %1 offset:%2" : "=&v"(r) : "v"(vb), "i"(OFF) : "memory"); return r;
}
template <int D0> __device__ __forceinline__ void pv_one(f32x16& od, int vb, bf16x8 pa0, bf16x8 pa1, bf16x8 pa2, bf16x8 pa3) {
    const s16x4 l0 = tr_read<v_rd_off(D0, 0, 0)>(vb), h0 = tr_read<v_rd_off(D0, 0, 1)>(vb), l1 = tr_read<v_rd_off(D0, 1, 0)>(vb), h1 = tr_read<v_rd_off(D0, 1, 1)>(vb);
    const s16x4 l2 = tr_read<v_rd_off(D0, 2, 0)>(vb), h2 = tr_read<v_rd_off(D0, 2, 1)>(vb), l3 = tr_read<v_rd_off(D0, 3, 0)>(vb), h3 = tr_read<v_rd_off(D0, 3, 1)>(vb);
    asm volatile("s_waitcnt lgkmcnt(0)" ::: "memory"); SBAR();
#define PK(L, H) (bf16x8){L[0], L[1], L[2], L[3], H[0], H[1], H[2], H[3]}
    od = __builtin_amdgcn_mfma_f32_32x32x16_bf16(pa0, PK(l0, h0), od, 0, 0, 0);
    od = __builtin_amdgcn_mfma_f32_32x32x16_bf16(pa1, PK(l1, h1), od, 0, 0, 0);
    od = __builtin_amdgcn_mfma_f32_32x32x16_bf16(pa2, PK(l2, h2), od, 0, 0, 0);
    od = __builtin_amdgcn_mfma_f32_32x32x16_bf16(pa3, PK(l3, h3), od, 0, 0, 0);
#undef PK
}
__device__ __forceinline__ void pv_d0(f32x16* o, int vb, bf16x8 pa0, bf16x8 pa1, bf16x8 pa2, bf16x8 pa3) {
    pv_one<0>(o[0], vb, pa0, pa1, pa2, pa3); pv_one<1>(o[1], vb, pa0, pa1, pa2, pa3); pv_one<2>(o[2], vb, pa0, pa1, pa2, pa3); pv_one<3>(o[3], vb, pa0, pa1, pa2, pa3);
}
__device__ __forceinline__ void qkt(f32x16& p0, f32x16& p1, const char* Ks, const bf16x8* qr, int comp, int r32, int hi) {
    const f32x16 zero = f32x16{};
#pragma unroll
    for (int d = 0; d < 4; ++d) { const int cb = ((comp * 4 + d) * 16 + hi * 8) * 2;
        const bf16x8 b0 = *reinterpret_cast<const bf16x8*>(Ks + KSWZ(r32, cb));
        const bf16x8 b1 = *reinterpret_cast<const bf16x8*>(Ks + KSWZ(32 + r32, cb));
        if (d == 0) { p0 = __builtin_amdgcn_mfma_f32_32x32x16_bf16(b0, qr[0], zero, 0, 0, 0); p1 = __builtin_amdgcn_mfma_f32_32x32x16_bf16(b1, qr[0], zero, 0, 0, 0); }
        else { p0 = __builtin_amdgcn_mfma_f32_32x32x16_bf16(b0, qr[d], p0, 0, 0, 0); p1 = __builtin_amdgcn_mfma_f32_32x32x16_bf16(b1, qr[d], p1, 0, 0, 0); } }
}
template <bool SHIFT> __device__ __forceinline__ void partialSM(f32x16& p0, float negM2) {
#pragma unroll
    for (int r = 0; r < 16; ++r) p0[r] = __builtin_amdgcn_exp2f(SHIFT ? p0[r] + negM2 : p0[r]);
}
template <bool SHIFT> __device__ __forceinline__ void finishSM(f32x16& p0, f32x16& p1, float negM2, float& l_reg, bf16x8& pa0, bf16x8& pa1, bf16x8& pa2, bf16x8& pa3) {
#pragma unroll
    for (int r = 0; r < 16; ++r) p1[r] = __builtin_amdgcn_exp2f(SHIFT ? p1[r] + negM2 : p1[r]);
    float ps = 0.f;
#pragma unroll
    for (int r = 0; r < 16; ++r) ps += p0[r];
#pragma unroll
    for (int r = 0; r < 16; ++r) ps += p1[r];
    l_reg += ps;
#define PK4(P, BASE, OUT) do { unsigned a0 = cvtpk(P[BASE + 0], P[BASE + 1]), a1 = cvtpk(P[BASE + 2], P[BASE + 3]);   \
    unsigned b0 = cvtpk(P[BASE + 4], P[BASE + 5]), b1 = cvtpk(P[BASE + 6], P[BASE + 7]);                              \
    auto r0 = __builtin_amdgcn_permlane32_swap(a0, b0, false, false); auto r1 = __builtin_amdgcn_permlane32_swap(a1, b1, false, false); \
    u32x4 w = {r0[0], r1[0], r0[1], r1[1]}; OUT = *reinterpret_cast<bf16x8*>(&w); } while (0)
    PK4(p0, 0, pa0); PK4(p0, 8, pa1); PK4(p1, 0, pa2); PK4(p1, 8, pa3);
#undef PK4
}

struct Tensors { const bf16_t *Q, *K, *V, *GA; bf16_t* MIX; const float* subw; float lam, negM2; };
__device__ __forceinline__ void epilogue(f32x16 (&o)[4], float l_reg, int b, int h, int qb, const Tensors& T, char* lds);

template <bool SHIFT> __device__ __forceinline__ void unit(int b, int h, int qb, const Tensors& T, char* lds) {
    const float negM2 = T.negM2;
    int tid = threadIdx.x; asm volatile("" : "+v"(tid));
    const int wid = __builtin_amdgcn_readfirstlane(tid >> 6), lane = tid & 63, r32 = lane & 31, hi = lane >> 5;
    const int comp = wid >> 2, rw = wid & 3;
    char* V_lds = lds + OFF_V; char* K_lds = lds + OFF_K;
    float* wsf = (float*)(lds + OFF_WS) + wid * 64;
    const long rowbase = (long)b * SEQ; const int q0 = qb * 128;
    const long hb = (long)(b * NH + h) * SEQ;
    const bf16_t* Kh = T.K + hb * LD; const bf16_t* Vh = T.V + hb * LD;
    bf16x8 qr[4];
    { const bf16_t* Qw = T.Q + (hb + q0 + rw * 32 + r32) * LD + comp * 64 + hi * 8;
#pragma unroll
      for (int d = 0; d < 4; ++d) qr[d] = *reinterpret_cast<const bf16x8*>(Qw + d * 16); }
    float l_reg = 0.f; f32x16 o[4];
#pragma unroll
    for (int d = 0; d < 4; ++d) o[d] = f32x16{};
    const int sr = tid >> 4, sc = (tid & 15) * 8, vst0 = v_st(sr, sc), vst1 = v_st(32 + sr, sc);
    const int vb0 = (int)(uintptr_t)V_lds + v_rd_base(lane);
    struct { bf16x8 vs0, vs1, ks0, ks1; } sr_[2];
#define LD8(p) (*reinterpret_cast<const bf16x8*>(p))
#define SLOAD(i, k0) do { sr_[i].vs0 = LD8(&Vh[(long)((k0) + sr) * LD + sc]); sr_[i].vs1 = LD8(&Vh[(long)((k0) + 32 + sr) * LD + sc]); \
    sr_[i].ks0 = LD8(&Kh[(long)((k0) + sr) * LD + sc]); sr_[i].ks1 = LD8(&Kh[(long)((k0) + 32 + sr) * LD + sc]); } while (0)
#define SWRITE(bb, i) do { *(bf16x8*)(V_lds + (bb) * SHM_V + vst0) = sr_[i].vs0;          \
    *(bf16x8*)(V_lds + (bb) * SHM_V + vst1) = sr_[i].vs1; const int kc = sc * 2;               \
    *(bf16x8*)(K_lds + (bb) * SHM_K + KSWZ(sr, kc)) = sr_[i].ks0;                       \
    *(bf16x8*)(K_lds + (bb) * SHM_K + KSWZ(32 + sr, kc)) = sr_[i].ks1; } while (0)
#define SWAIT() asm volatile("s_waitcnt vmcnt(4)" ::: "memory")
    f32x16 pA0, pA1, pB0, pB1; bf16x8 pa0, pa1, pa2, pa3;
    constexpr int SE = 0, SO = 1;
    SLOAD(SE, 0); asm volatile("s_waitcnt vmcnt(0)" ::: "memory"); SWRITE(0, SE); __syncthreads();
    qkt(pA0, pA1, K_lds, qr, comp, r32, hi); partialSM<SHIFT>(pA0, negM2);
    SLOAD(SO, KVBLK); SLOAD(SE, 2 * KVBLK);
    SWAIT(); SWRITE(1, SO); __syncthreads();
#pragma unroll 1
    for (int j = 1; j + 1 < NT; j += 2) {
        SBAR(); qkt(pB0, pB1, K_lds + SHM_K, qr, comp, r32, hi);
        finishSM<SHIFT>(pA0, pA1, negM2, l_reg, pa0, pa1, pa2, pa3); SBAR();
        SLOAD(SO, (j + 2) * KVBLK); SBAR();
        pv_d0(o, vb0, pa0, pa1, pa2, pa3); partialSM<SHIFT>(pB0, negM2);
        __syncthreads(); SWAIT(); SWRITE(0, SE);
        __syncthreads();
        SBAR(); qkt(pA0, pA1, K_lds, qr, comp, r32, hi);
        finishSM<SHIFT>(pB0, pB1, negM2, l_reg, pa0, pa1, pa2, pa3); SBAR();
        SLOAD(SE, (j + 3 < NT ? j + 3 : NT - 1) * KVBLK); SBAR();
        pv_d0(o, vb0 + SHM_V, pa0, pa1, pa2, pa3); partialSM<SHIFT>(pA0, negM2);
        __syncthreads(); SWAIT(); SWRITE(1, SO);
        __syncthreads();
    }
    SBAR(); qkt(pB0, pB1, K_lds + SHM_K, qr, comp, r32, hi);
    finishSM<SHIFT>(pA0, pA1, negM2, l_reg, pa0, pa1, pa2, pa3); SBAR();
    pv_d0(o, vb0, pa0, pa1, pa2, pa3); partialSM<SHIFT>(pB0, negM2);
    finishSM<SHIFT>(pB0, pB1, negM2, l_reg, pa0, pa1, pa2, pa3); SBAR();
    pv_d0(o, vb0 + SHM_V, pa0, pa1, pa2, pa3);
#undef SLOAD
#undef SWRITE
#undef SWAIT
#undef LD8
    epilogue(o, l_reg, b, h, qb, T, lds);
}
__device__ __forceinline__ void epilogue(f32x16 (&o)[4], float l_reg, int b, int h, int qb, const Tensors& T, char* lds) {
    int tid = threadIdx.x; asm volatile("" : "+v"(tid));
    const int wid = __builtin_amdgcn_readfirstlane(tid >> 6), lane = tid & 63, r32 = lane & 31, hi = lane >> 5;
    const int comp = wid >> 2, rw = wid & 3;
    float* wsf = (float*)(lds + OFF_WS) + wid * 64;
    const long rowbase = (long)b * SEQ; const int q0 = qb * 128;
    { auto rr = __builtin_amdgcn_permlane32_swap(__float_as_uint(l_reg), __float_as_uint(l_reg), false, false); l_reg = __uint_as_float(rr[0]) + __uint_as_float(rr[1]); }
    if (hi == 0) wsf[r32] = l_reg;
    asm volatile("s_waitcnt lgkmcnt(0)" ::: "memory");
    float rli[16];
#pragma unroll
    for (int r = 0; r < 16; ++r) rli[r] = __builtin_amdgcn_rcpf(wsf[crow(r, hi)]);
    __syncthreads();
    float* X = (float*)lds + rw * 4096;
    if (comp == 1) {
        const float lam = T.lam;
#pragma unroll
        for (int r = 0; r < 16; ++r) { const float f = rli[r] * lam;
#pragma unroll
            for (int d = 0; d < 4; ++d) X[crow(r, hi) * 128 + d * 32 + r32] = o[d][r] * f; }
    }
    __syncthreads();
    if (comp == 0) {
        float sw[4];
#pragma unroll
        for (int d = 0; d < 4; ++d) sw[d] = T.subw[d * 32 + r32] * (1.0f - LAM_INIT);
#pragma unroll
        for (int r = 0; r < 16; ++r) {
            float a[4]; float ss = 0.f;
#pragma unroll
            for (int d = 0; d < 4; ++d) { a[d] = o[d][r] * rli[r] - X[crow(r, hi) * 128 + d * 32 + r32]; ss += a[d] * a[d]; }
            ss += __shfl_xor(ss, 1); ss += __shfl_xor(ss, 2); ss += __shfl_xor(ss, 4); ss += __shfl_xor(ss, 8); ss += __shfl_xor(ss, 16);
            const float rs = 1.0f / sqrtf(ss * (1.0f / 128.0f) + EPSN);
#pragma unroll
            for (int d = 0; d < 4; ++d) X[crow(r, hi) * 128 + d * 32 + r32] = a[d] * rs * sw[d];
        }
    }
    __syncthreads();
#pragma unroll
    for (int i = 0; i < 4; ++i) {
        const int idx = i * 64 + lane, row = comp * 16 + (idx >> 4), ch = idx & 15;
        const f32x4 z0 = *(const f32x4*)(X + row * 128 + ch * 8), z1 = *(const f32x4*)(X + row * 128 + ch * 8 + 4);
        const long grow = rowbase + q0 + rw * 32 + row;
        const u32x4 g = *(const u32x4*)(T.GA + grow * AW + h * 128 + ch * 8);
        u32x4 w;
        w.x = cvtpk(z0[0] * bf_lo(g.x), z0[1] * bf_hi(g.x)); w.y = cvtpk(z0[2] * bf_lo(g.y), z0[3] * bf_hi(g.y));
        w.z = cvtpk(z1[0] * bf_lo(g.z), z1[1] * bf_hi(g.z)); w.w = cvtpk(z1[2] * bf_lo(g.w), z1[3] * bf_hi(g.w));
        *(u32x4*)(T.MIX + grow * DM + h * 128 + ch * 8) = w;
    }
    __syncthreads();
}
}


namespace att2 {
#ifndef DEBUG_SYNC_COPY
#define DEBUG_SYNC_COPY 0
#endif
using att::crow; using att::Tensors; using att::tr_read; using att::v_rd_off; using att::v_rd_base;
constexpr int NT = SEQ / 64, SHM = 16384;
constexpr int OFF_Q = 0, OFF_V = 65536, OFF_K = 98304, OFF_WS = 131072;
typedef LAS unsigned char* ldsp;
__device__ __forceinline__ void glds16s(unsigned voff, const void* sbase, unsigned lds_dst) { unsigned keep;
    asm volatile("s_mov_b32 %0, m0\n\ts_mov_b32 m0, %3\n\ts_nop 0\n\tglobal_load_lds_dwordx4 %1, %2\n\ts_mov_b32 m0, %0" : "=&s"(keep) : "v"(voff), "s"(sbase), "s"(lds_dst) : "memory"); }
typedef __bf16 bf16x2_t __attribute__((ext_vector_type(2)));
__device__ __forceinline__ unsigned cvtpk_s(float lo, float hi) { f32x2 v = {lo, hi}; bf16x2_t b = __builtin_convertvector(v, bf16x2_t); return __builtin_bit_cast(unsigned, b); }
template <int H, int D0> __device__ __forceinline__ void v_rd4(s16x4 (&f)[4], int vb) {
    f[0] = tr_read<v_rd_off(D0, 2 * H, 0)>(vb); f[1] = tr_read<v_rd_off(D0, 2 * H, 1)>(vb); f[2] = tr_read<v_rd_off(D0, 2 * H + 1, 0)>(vb); f[3] = tr_read<v_rd_off(D0, 2 * H + 1, 1)>(vb);
}
__device__ __forceinline__ void pv_mma(f32x16& oa, f32x16& ob, const s16x4 (&f)[4], const bf16x8 (&pa)[2], const bf16x8 (&pb)[2]) {
#define PK(L, H_) (bf16x8){L[0], L[1], L[2], L[3], H_[0], H_[1], H_[2], H_[3]}
    const bf16x8 v0 = PK(f[0], f[1]), v1 = PK(f[2], f[3]);
#undef PK
    oa = __builtin_amdgcn_mfma_f32_32x32x16_bf16(pa[0], v0, oa, 0, 0, 0);
    ob = __builtin_amdgcn_mfma_f32_32x32x16_bf16(pb[0], v0, ob, 0, 0, 0);
    oa = __builtin_amdgcn_mfma_f32_32x32x16_bf16(pa[1], v1, oa, 0, 0, 0);
    ob = __builtin_amdgcn_mfma_f32_32x32x16_bf16(pb[1], v1, ob, 0, 0, 0);
}
template <int H> __device__ __forceinline__ void pv_half(f32x16 (&o0)[4], f32x16 (&o1)[4], int vb, const bf16x8 (&pa)[2], const bf16x8 (&pb)[2]) {
    s16x4 fa[4], fb[4];
    SBAR();
    v_rd4<H, 0>(fa, vb); v_rd4<H, 1>(fb, vb);
    asm volatile("s_waitcnt lgkmcnt(4)" ::: "memory"); SBAR();
    pv_mma(o0[0], o1[0], fa, pa, pb); SBAR();
    v_rd4<H, 2>(fa, vb);
    asm volatile("s_waitcnt lgkmcnt(4)" ::: "memory"); SBAR();
    pv_mma(o0[1], o1[1], fb, pa, pb); SBAR();
    v_rd4<H, 3>(fb, vb);
    asm volatile("s_waitcnt lgkmcnt(4)" ::: "memory"); SBAR();
    pv_mma(o0[2], o1[2], fa, pa, pb); SBAR();
    asm volatile("s_waitcnt lgkmcnt(0)" ::: "memory"); SBAR();
    pv_mma(o0[3], o1[3], fb, pa, pb); SBAR();
}
template <int C, int H> __device__ __forceinline__ void qkt_half(f32x16& p, ldsp Kb, ldsp Qw, const int (&fa)[4]) {
    const f32x16 zero = f32x16{};
#pragma unroll
    for (int d = 0; d < 4; ++d) {
        const bf16x8 q = *(const LAS bf16x8*)(Qw + fa[d] + C * 128);
        const bf16x8 kf = *(const LAS bf16x8*)(Kb + fa[d] + C * 128 + H * 8192);
        if (d == 0) p = __builtin_amdgcn_mfma_f32_32x32x16_bf16(kf, q, zero, 0, 0, 0);
        else p = __builtin_amdgcn_mfma_f32_32x32x16_bf16(kf, q, p, 0, 0, 0); }
}
template <int C, int H> __device__ __forceinline__ void qkt_half_r(f32x16& p, ldsp Kb, const bf16x8 (&qa)[4], const int (&fa)[4]) {
    const f32x16 zero = f32x16{};
#pragma unroll
    for (int d = 0; d < 4; ++d) {
        const bf16x8 kf = *(const LAS bf16x8*)(Kb + fa[d] + C * 128 + H * 8192);
        if (d == 0) p = __builtin_amdgcn_mfma_f32_32x32x16_bf16(kf, qa[0], zero, 0, 0, 0);
        else p = __builtin_amdgcn_mfma_f32_32x32x16_bf16(kf, qa[d], p, 0, 0, 0); }
}
template <bool SHIFT> __device__ __forceinline__ void softmax_half(f32x16& p, float negM2, float& l_reg, bf16x8 (&pa)[2]) {
#pragma unroll
    for (int r = 0; r < 16; ++r) p[r] = __builtin_amdgcn_exp2f(SHIFT ? p[r] + negM2 : p[r]);
#pragma unroll
    for (int r = 0; r < 16; ++r) l_reg += p[r];
#define PK4(P, BASE, OUT) do { unsigned a0 = cvtpk_s(P[BASE + 0], P[BASE + 1]), a1 = cvtpk_s(P[BASE + 2], P[BASE + 3]);   \
    unsigned b0 = cvtpk_s(P[BASE + 4], P[BASE + 5]), b1 = cvtpk_s(P[BASE + 6], P[BASE + 7]);                              \
    auto r0 = __builtin_amdgcn_permlane32_swap(a0, b0, false, false); auto r1 = __builtin_amdgcn_permlane32_swap(a1, b1, false, false); \
    u32x4 w = {r0[0], r1[0], r0[1], r1[1]}; OUT = *reinterpret_cast<bf16x8*>(&w); } while (0)
    PK4(p, 0, pa[0]); PK4(p, 8, pa[1]);
#undef PK4
}
template <bool SHIFT, int H, class Mid> __device__ __forceinline__ void half_tile(ldsp Kb, int vb, ldsp Qw, const int (&fa)[4], const bf16x8 (&qa)[4], const bf16x8 (&qb_)[4], float negM2, f32x16 (&o0)[4], f32x16 (&o1)[4], float& l0, float& l1, Mid&& mid) {
    f32x16 sa, sb; bf16x8 pa[2], pb[2];
    asm volatile("" : "+v"(l0) : "v"(l1));
    qkt_half_r<0, H>(sa, Kb, qa, fa);
    qkt_half_r<1, H>(sb, Kb, qb_, fa);
    if (H == 1) {
#pragma unroll
        for (int i = 0; i < 8; ++i) { __builtin_amdgcn_sched_group_barrier(0x008, 1, 0); __builtin_amdgcn_sched_group_barrier(0x100, 2, 0); }
    }
    softmax_half<SHIFT>(sa, negM2, l0, pa);
    asm volatile("" : "+v"(l1) : "v"(l0));
    SBAR();
    s16x4 f0[4], f1[4], f2[4], f3[4];
    v_rd4<H, 0>(f0, vb); v_rd4<H, 1>(f1, vb); v_rd4<H, 2>(f2, vb); v_rd4<H, 3>(f3, vb);
    asm volatile("s_waitcnt lgkmcnt(0)" ::: "memory"); SBAR();
    mid();
    SBAR();
#define PK(L, H_) (bf16x8){L[0], L[1], L[2], L[3], H_[0], H_[1], H_[2], H_[3]}
    const bf16x8 v00 = PK(f0[0], f0[1]), v01 = PK(f0[2], f0[3]), v10 = PK(f1[0], f1[1]), v11 = PK(f1[2], f1[3]);
    const bf16x8 v20 = PK(f2[0], f2[1]), v21 = PK(f2[2], f2[3]), v30 = PK(f3[0], f3[1]), v31 = PK(f3[2], f3[3]);
#undef PK
    o0[0] = __builtin_amdgcn_mfma_f32_32x32x16_bf16(pa[0], v00, o0[0], 0, 0, 0);
    o0[1] = __builtin_amdgcn_mfma_f32_32x32x16_bf16(pa[0], v10, o0[1], 0, 0, 0);
    o0[2] = __builtin_amdgcn_mfma_f32_32x32x16_bf16(pa[0], v20, o0[2], 0, 0, 0);
    o0[3] = __builtin_amdgcn_mfma_f32_32x32x16_bf16(pa[0], v30, o0[3], 0, 0, 0);
    o0[0] = __builtin_amdgcn_mfma_f32_32x32x16_bf16(pa[1], v01, o0[0], 0, 0, 0);
    o0[1] = __builtin_amdgcn_mfma_f32_32x32x16_bf16(pa[1], v11, o0[1], 0, 0, 0);
    o0[2] = __builtin_amdgcn_mfma_f32_32x32x16_bf16(pa[1], v21, o0[2], 0, 0, 0);
    o0[3] = __builtin_amdgcn_mfma_f32_32x32x16_bf16(pa[1], v31, o0[3], 0, 0, 0);
    softmax_half<SHIFT>(sb, negM2, l1, pb);
#pragma unroll
    for (int i = 0; i < 8; ++i) { __builtin_amdgcn_sched_group_barrier(0x008, 1, 0); __builtin_amdgcn_sched_group_barrier(0x402, 6, 0); }
    o1[0] = __builtin_amdgcn_mfma_f32_32x32x16_bf16(pb[0], v00, o1[0], 0, 0, 0);
    o1[1] = __builtin_amdgcn_mfma_f32_32x32x16_bf16(pb[0], v10, o1[1], 0, 0, 0);
    o1[2] = __builtin_amdgcn_mfma_f32_32x32x16_bf16(pb[0], v20, o1[2], 0, 0, 0);
    o1[3] = __builtin_amdgcn_mfma_f32_32x32x16_bf16(pb[0], v30, o1[3], 0, 0, 0);
    o1[0] = __builtin_amdgcn_mfma_f32_32x32x16_bf16(pb[1], v01, o1[0], 0, 0, 0);
    o1[1] = __builtin_amdgcn_mfma_f32_32x32x16_bf16(pb[1], v11, o1[1], 0, 0, 0);
    o1[2] = __builtin_amdgcn_mfma_f32_32x32x16_bf16(pb[1], v21, o1[2], 0, 0, 0);
    o1[3] = __builtin_amdgcn_mfma_f32_32x32x16_bf16(pb[1], v31, o1[3], 0, 0, 0);
}
template <bool SHIFT, class Mid> __device__ __forceinline__ void tile(ldsp Kb, int vb, ldsp Qw, const int (&fa)[4], const bf16x8 (&qa)[4], const bf16x8 (&qb_)[4], float negM2, f32x16 (&o0)[4], f32x16 (&o1)[4], float& l0, float& l1, Mid&& mid) {
    half_tile<SHIFT, 0>(Kb, vb, Qw, fa, qa, qb_, negM2, o0, o1, l0, l1, [] {});
    half_tile<SHIFT, 1>(Kb, vb, Qw, fa, qa, qb_, negM2, o0, o1, l0, l1, mid);
}
__device__ __forceinline__ void epilogue2(f32x16 (&o0)[4], f32x16 (&o1)[4], float l0, float l1, int b, int h, int qb, const Tensors& T, char* lds);

template <bool SHIFT> __device__ __forceinline__ void unit(int b, int h, int qb, const Tensors& T, char* ldsc) {
    int tid = threadIdx.x; asm volatile("" : "+v"(tid));
    const int wid = __builtin_amdgcn_readfirstlane(tid >> 6), lane = tid & 63, r32 = lane & 31, hi = lane >> 5;
    ldsp lds = (ldsp)ldsc;
    const long hb = (long)(b * NH + h) * SEQ;
    const bf16_t* Kh = T.K + hb * 128; const bf16_t* Vh = T.V + hb * 128;
    const unsigned lds0 = (unsigned)(uintptr_t)ldsc;
    const unsigned kdst = lds0 + OFF_K + wid * 2048, vdst = lds0 + OFF_V + wid * 2048;
    unsigned dko[2], dvo[2];
#pragma unroll
    for (int i_ = 0; i_ < 2; ++i_) { const int c_ = wid * 2 + i_;
        const int row_ = 4 * c_ + (lane >> 4), pc_ = lane & 15; dko[i_] = (unsigned)(row_ * 128 + ((pc_ ^ (row_ & 7)) * 8)) * 2u;
        const int s_ = 2 * c_ + (lane >> 5), kk_ = (s_ >> 2) * 8 + ((lane & 31) >> 2), col_ = (s_ & 3) * 32 + (lane & 3) * 8;
        const int k_ = (kk_ & ~0xC) | ((kk_ & 4) << 1) | ((kk_ & 8) >> 1); dvo[i_] = (unsigned)(k_ * 128 + col_) * 2u; }
#define DMA_TILE(t, buf) do { const char* kt_ = (const char*)Kh + (size_t)(t) * 16384; const char* vt_ = (const char*)Vh + (size_t)(t) * 16384; \
        glds16s(dko[0], kt_, kdst + (buf) * SHM); glds16s(dvo[0], vt_, vdst + (buf) * SHM); \
        glds16s(dko[1], kt_, kdst + (buf) * SHM + 1024); glds16s(dvo[1], vt_, vdst + (buf) * SHM + 1024); } while (0)
    DMA_TILE(0, 0);
    ldsp Qw = lds + OFF_Q + wid * 8192;
    { const bf16_t* Qg = T.Q + (hb + qb * 256 + wid * 32) * 128;
      bf16x8 qv[8];
#pragma unroll
      for (int i = 0; i < 8; ++i) qv[i] = *reinterpret_cast<const bf16x8*>(Qg + (i * 4 + (lane >> 4)) * 128 + (lane & 15) * 8);
#pragma unroll
      for (int i = 0; i < 8; ++i) { const int row = i * 4 + (lane >> 4); *(LAS bf16x8*)(Qw + row * 256 + (((lane & 15) * 16) ^ ((row & 7) << 4))) = qv[i]; } }
    const float negM2 = T.negM2;
    float l0 = 0.f, l1 = 0.f; f32x16 o0[4], o1[4];
#pragma unroll
    for (int d = 0; d < 4; ++d) { o0[d] = f32x16{}; o1[d] = f32x16{}; }
    const int vb0 = (int)(uintptr_t)(lds + OFF_V) + v_rd_base(lane);
    int fa[4];
#pragma unroll
    for (int d = 0; d < 4; ++d) fa[d] = r32 * 256 + ((d * 32 + hi * 16) ^ ((r32 & 7) << 4));
#define OPEN_TILE() do { asm volatile("s_waitcnt vmcnt(0) lgkmcnt(0)" ::: "memory"); __builtin_amdgcn_s_barrier(); asm volatile("" ::: "memory"); } while (0)
    OPEN_TILE(); DMA_TILE(1, 1);
    if (wid >= 4) __builtin_amdgcn_s_setprio(1);
    bf16x8 qa[4], qb_[4];
#pragma unroll
    for (int d = 0; d < 4; ++d) { qa[d] = *(const LAS bf16x8*)(Qw + fa[d]); qb_[d] = *(const LAS bf16x8*)(Qw + fa[d] + 128); }
#pragma unroll 1
    for (int t = 0; t < NT; t += 2) {
        tile<SHIFT>(lds + OFF_K, vb0, Qw, fa, qa, qb_, negM2, o0, o1, l0, l1, [&] { OPEN_TILE(); DMA_TILE((t + 2 < NT ? t + 2 : NT - 1), 0); });
        tile<SHIFT>(lds + OFF_K + SHM, vb0 + SHM, Qw, fa, qa, qb_, negM2, o0, o1, l0, l1, [&] { OPEN_TILE(); DMA_TILE((t + 3 < NT ? t + 3 : NT - 1), 1); });
    }
#undef DMA_TILE
#undef OPEN_TILE
    __builtin_amdgcn_s_setprio(0);
    asm volatile("s_waitcnt vmcnt(0) lgkmcnt(0)" ::: "memory"); __builtin_amdgcn_s_barrier(); asm volatile("" ::: "memory");
    epilogue2(o0, o1, l0, l1, b, h, qb, T, ldsc);
}
__device__ __forceinline__ void epilogue2(f32x16 (&o0)[4], f32x16 (&o1)[4], float l0, float l1, int b, int h, int qb, const Tensors& T, char* lds) {
    int tid = threadIdx.x; asm volatile("" : "+v"(tid));
    const int wid = __builtin_amdgcn_readfirstlane(tid >> 6), lane = tid & 63, r32 = lane & 31, hi = lane >> 5;
    float* wsf = (float*)(lds + OFF_WS) + wid * 64;
    { auto rr = __builtin_amdgcn_permlane32_swap(__float_as_uint(l0), __float_as_uint(l0), false, false); l0 = __uint_as_float(rr[0]) + __uint_as_float(rr[1]); }
    { auto rr = __builtin_amdgcn_permlane32_swap(__float_as_uint(l1), __float_as_uint(l1), false, false); l1 = __uint_as_float(rr[0]) + __uint_as_float(rr[1]); }
    if (hi == 0) { wsf[r32] = l0; wsf[32 + r32] = l1; }
    asm volatile("s_waitcnt lgkmcnt(0)" ::: "memory");
    float* X = (float*)(lds + wid * 16384);
    float sw[4];
#pragma unroll
    for (int d = 0; d < 4; ++d) sw[d] = T.subw[d * 32 + r32] * (1.0f - LAM_INIT);
    const float lam = T.lam;
#pragma unroll
    for (int r = 0; r < 16; ++r) {
        const int row = crow(r, hi);
        const float f1 = lam * __builtin_amdgcn_rcpf(wsf[32 + row]);
#pragma unroll
        for (int d = 0; d < 4; ++d) X[row * 128 + d * 32 + r32] = o1[d][r] * f1;
    }
    asm volatile("s_waitcnt lgkmcnt(0)" ::: "memory"); SBAR();
#pragma unroll
    for (int r = 0; r < 16; ++r) {
        const int row = crow(r, hi);
        const float f0 = __builtin_amdgcn_rcpf(wsf[row]);
        float a[4]; float ss = 0.f;
#pragma unroll
        for (int d = 0; d < 4; ++d) { a[d] = o0[d][r] * f0 - X[row * 128 + d * 32 + r32]; ss += a[d] * a[d]; }
        ss += __shfl_xor(ss, 1); ss += __shfl_xor(ss, 2); ss += __shfl_xor(ss, 4); ss += __shfl_xor(ss, 8); ss += __shfl_xor(ss, 16);
        const float rs = 1.0f / sqrtf(ss * (1.0f / 128.0f) + EPSN);
#pragma unroll
        for (int d = 0; d < 4; ++d) X[row * 128 + d * 32 + r32] = a[d] * rs * sw[d];
        SBAR();
    }
    asm volatile("s_waitcnt lgkmcnt(0)" ::: "memory");
    const long grow0 = (long)b * SEQ + qb * 256 + wid * 32;
#pragma unroll
    for (int i = 0; i < 8; ++i) {
        const int idx = i * 64 + lane, row = idx >> 4, ch = idx & 15;
        const f32x4 z0 = *(const f32x4*)(X + row * 128 + ch * 8), z1 = *(const f32x4*)(X + row * 128 + ch * 8 + 4);
        const u32x4 g = *(const u32x4*)(T.GA + (grow0 + row) * AW + h * 128 + ch * 8);
        u32x4 w;
        w.x = cvtpk(z0[0] * bf_lo(g.x), z0[1] * bf_hi(g.x)); w.y = cvtpk(z0[2] * bf_lo(g.y), z0[3] * bf_hi(g.y));
        w.z = cvtpk(z1[0] * bf_lo(g.z), z1[1] * bf_hi(g.z)); w.w = cvtpk(z1[2] * bf_lo(g.w), z1[3] * bf_hi(g.w));
        *(u32x4*)(T.MIX + (grow0 + row) * LDP + h * 128 + ch * 8) = w;
    }
    __syncthreads();
}
}

template <int LO> __device__ __forceinline__ void pool_dg(const unsigned (&raw)[47], bf16_t* dst, int p0) {
    constexpr int HI = LO - 1, DGS = 1032;
    float sx = 0.f, sy = 0.f;
#pragma unroll
    for (int j = 8 - LO; j <= 8 + HI; ++j) { sx += bf_lo(raw[j]); sy += bf_hi(raw[j]); }
#pragma unroll
    for (int i = 0; i < 32; ++i) {
        const int p = p0 + i;
        const int cnt = min(p + HI, SEQ - 1) - max(p - LO, 0) + 1;
        const float rc = 1.0f / (float)cnt;
        *(unsigned*)(dst + i * DGS) = cvtpk(sx * rc - bf_lo(raw[i + 8]), sy * rc - bf_hi(raw[i + 8]));
        if (i < 31) { sx += bf_lo(raw[i + 8 + HI + 1]) - bf_lo(raw[i + 8 - LO]); sy += bf_hi(raw[i + 8 + HI + 1]) - bf_hi(raw[i + 8 - LO]); }
    }
}
__device__ __forceinline__ void pool_job(int blk, const bf16_t* U, const bf16_t* GP, const bf16_t* WPT, const float* pscale, bf16_t* MIX, char* lds) {
    int tid = threadIdx.x; asm volatile("" : "+v"(tid));
    const int wid = __builtin_amdgcn_readfirstlane(tid >> 6), lane = tid & 63, r32 = lane & 31, hi = lane >> 5;
    constexpr int DGS = 1032;
    bf16_t* dgs = (bf16_t*)lds;
    const int t0 = blk * 32, b = t0 / SEQ, p0 = t0 % SEQ;
    {
        const int ch = 2 * tid, g = wid >> 1;
        const bf16_t* base = U + (size_t)b * SEQ * AW + ch;
        unsigned raw[47];
#pragma unroll
        for (int j = 0; j < 47; ++j) { const int p = p0 - 8 + j, pc = min(max(p, 0), SEQ - 1); raw[j] = *(const unsigned*)(base + (size_t)pc * AW); }
#pragma unroll
        for (int j = 0; j < 47; ++j) { const int p = p0 - 8 + j; if (p < 0 || p >= SEQ) raw[j] = 0u; }
        if (g == 0) pool_dg<1>(raw, dgs + ch, p0); else if (g == 1) pool_dg<2>(raw, dgs + ch, p0); else if (g == 2) pool_dg<4>(raw, dgs + ch, p0); else pool_dg<8>(raw, dgs + ch, p0);
    }
    __syncthreads();
    {
        const int g = wid >> 1, nbase = (wid & 1) * 128;
        f32x16 acc[4];
#pragma unroll
        for (int nb = 0; nb < 4; ++nb) acc[nb] = f32x16{};
        const bf16_t* wp = WPT + ((size_t)(g * 256 + nbase + r32) * 256 + hi * 8);
        const bf16_t* ap = dgs + r32 * DGS + g * 256 + hi * 8;
#pragma unroll 4
        for (int ks = 0; ks < 16; ++ks) {
            const bf16x8 a = *reinterpret_cast<const bf16x8*>(ap + ks * 16);
#pragma unroll
            for (int nb = 0; nb < 4; ++nb) {
                const bf16x8 bb = *reinterpret_cast<const bf16x8*>(wp + (size_t)nb * 32 * 256 + ks * 16);
                acc[nb] = __builtin_amdgcn_mfma_f32_32x32x16_bf16(a, bb, acc[nb], 0, 0, 0);
            }
        }
        bf16_t* stg = (bf16_t*)(lds + 66048);
#pragma unroll
        for (int nb = 0; nb < 4; ++nb) {
            const int dg = g * 256 + nbase + nb * 32 + r32;
            const float ps = pscale[dg];
#pragma unroll
            for (int r = 0; r < 16; ++r) { const float y = acc[nb][r] * ps; stg[att::crow(r, hi) * 1024 + dg] = (bf16_t)(cvtpk(y, y) & 0xffffu); }
        }
    }
    __syncthreads();
    {
        const bf16_t* stg = (const bf16_t*)(lds + 66048);
#pragma unroll
        for (int i = 0; i < 8; ++i) {
            const int idx = i * 512 + tid, row = idx >> 7, ch = idx & 127;
            const u32x4 y = *(const u32x4*)(stg + row * 1024 + ch * 8);
            const size_t tok = (size_t)t0 + row;
            const u32x4 gq = *(const u32x4*)(GP + tok * AW + ch * 8);
            u32x4 w;
            w.x = cvtpk(bf_lo(y.x) * bf_lo(gq.x), bf_hi(y.x) * bf_hi(gq.x)); w.y = cvtpk(bf_lo(y.y) * bf_lo(gq.y), bf_hi(y.y) * bf_hi(gq.y));
            w.z = cvtpk(bf_lo(y.z) * bf_lo(gq.z), bf_hi(y.z) * bf_hi(gq.z)); w.w = cvtpk(bf_lo(y.w) * bf_lo(gq.w), bf_hi(y.w) * bf_hi(gq.w));
            *(u32x4*)(MIX + tok * LDP + AW + ch * 8) = w;
        }
    }
    __syncthreads();
}

#define XB_TMO      128
#define XB_XCNT(j)  (256  + 64 * (j))
#define XB_XSUB(j)  (1280 + 64 * (j))
#define XB_XGEN(j)  (2304 + 64 * (j))
#define XB_TOP      3328
#define XB_TOPGEN   3392
#define XCD_BAR_WORDS 3456
#define XB_SPIN_CAP (1u << 18)

__device__ __forceinline__ unsigned xb_ld(unsigned* p)              { return __hip_atomic_load(p, __ATOMIC_RELAXED, __HIP_MEMORY_SCOPE_AGENT); }
__device__ __forceinline__ unsigned xb_add(unsigned* p, unsigned v) { return __hip_atomic_fetch_add(p, v, __ATOMIC_RELAXED, __HIP_MEMORY_SCOPE_AGENT); }
__device__ __forceinline__ unsigned xb_xcc_id() { return (unsigned)__builtin_amdgcn_s_getreg((3 << 11) | 20) & 0xFu; }
#define XB_SPIN(cond, bar) do { unsigned _sp = 0; while (cond) { __builtin_amdgcn_s_sleep(1); \
    if ((++_sp & 255u) == 0u) { if (xb_ld(&(bar)[XB_TMO])) break; if (_sp > XB_SPIN_CAP) { atomicAdd(&(bar)[XB_TMO], 1u); break; } } } } while (0)

struct XcdBarrier {
    unsigned* bar; unsigned x;
    volatile LAS unsigned* st;
};

__device__ __forceinline__ XcdBarrier xcd_barrier_post(unsigned* bar, volatile LAS unsigned* st) {
    XcdBarrier b; b.bar = bar; b.x = xb_xcc_id(); b.st = st;
    if (threadIdx.x == 0) (void)xb_add(&bar[XB_XCNT(b.x)], 1u);
    return b;
}
__device__ __forceinline__ void xcd_barrier_complete(unsigned* bar, unsigned x, unsigned& nloc, unsigned& nx) {
    const unsigned G = gridDim.x * gridDim.y * gridDim.z;
    unsigned sum, cnt, mine, sp = 0u;
    for (;;) {
        sum = 0u; cnt = 0u; mine = 0u;
#pragma unroll
        for (unsigned j = 0; j < 16; ++j) { const unsigned c = xb_ld(&bar[XB_XCNT(j)]); sum += c; cnt += (c > 0u) ? 1u : 0u; mine = (j == x) ? c : mine; }
        if (sum == G) break;
        __builtin_amdgcn_s_sleep(1);
        if ((++sp & 255u) == 0u) { if (xb_ld(&bar[XB_TMO])) break; if (sp > XB_SPIN_CAP) { atomicAdd(&bar[XB_TMO], 1u); break; } }
    }
    nloc = mine > 0u ? mine : 1u; nx = cnt > 0u ? cnt : 1u;
}

__device__ __forceinline__ void xcd_barrier(const XcdBarrier& b) {
    asm volatile("s_waitcnt vmcnt(0)" ::: "memory");
    __syncthreads();
    if (threadIdx.x == 0) {
        unsigned* bar = b.bar;
        __builtin_amdgcn_s_waitcnt(0);
        unsigned nloc = b.st[0], nx = b.st[1];
        if (nloc == 0u) { xcd_barrier_complete(bar, b.x, nloc, nx); b.st[0] = nloc; b.st[1] = nx; }
        const unsigned old = xb_add(&bar[XB_XSUB(b.x)], 1u);
        const unsigned gen = old / nloc;
        if (old + 1u == (gen + 1u) * nloc) {
            __builtin_amdgcn_fence(__ATOMIC_RELEASE, "agent");
            asm volatile("s_waitcnt vmcnt(0)" ::: "memory");
            const unsigned og = xb_add(&bar[XB_TOP], 1u);
            const unsigned tg = og / nx;
            if (og + 1u == (tg + 1u) * nx) xb_add(&bar[XB_TOPGEN], 1u);
            else XB_SPIN(xb_ld(&bar[XB_TOPGEN]) == tg, bar);
            __builtin_amdgcn_fence(__ATOMIC_ACQUIRE, "agent");
            xb_add(&bar[XB_XGEN(b.x)], 1u);
            asm volatile("s_waitcnt vmcnt(0)" ::: "memory");
        } else {
            XB_SPIN(xb_ld(&bar[XB_XGEN(b.x)]) == gen, bar);
            __builtin_amdgcn_fence(__ATOMIC_ACQUIRE, "agent");
            asm volatile("s_waitcnt vmcnt(0)" ::: "memory");
        }
    }
    __syncthreads();
}

struct TItem { const float* W; bf16_t* WT; const float* kscale; int K, N, k0, n0, drow, ldw; };
__device__ __forceinline__ void titem_load(const TItem& t, float (&tv)[32], int lane) {
#pragma unroll
    for (int i = 0; i < 32; ++i) tv[i] = t.W[(size_t)(t.k0 + 2 * i + (lane >> 5)) * t.N + t.n0 + (lane & 31)];
}
__device__ __forceinline__ void titem_finish(const TItem& t, float (&tv)[32], LAS float* scr, int lane) {
    if (t.kscale) {
#pragma unroll
        for (int i = 0; i < 32; ++i) tv[i] *= t.kscale[t.k0 + 2 * i + (lane >> 5)];
    }
#pragma unroll
    for (int i = 0; i < 32; ++i) scr[(2 * i + (lane >> 5)) * 33 + (lane & 31)] = tv[i];
    asm volatile("s_waitcnt lgkmcnt(0)" ::: "memory");
    const int c = lane & 7;
#pragma unroll
    for (int j = 0; j < 4; ++j) { const int n = (lane >> 3) + 8 * j; const LAS float* s = scr + (8 * c) * 33 + n;
        u32x4 o; o.x = cvtpk(s[0 * 33], s[1 * 33]); o.y = cvtpk(s[2 * 33], s[3 * 33]); o.z = cvtpk(s[4 * 33], s[5 * 33]); o.w = cvtpk(s[6 * 33], s[7 * 33]);
        *(u32x4*)(t.WT + (size_t)(t.drow + n) * t.ldw + t.k0 + 8 * c) = o; }
    asm volatile("s_waitcnt lgkmcnt(0)" ::: "memory");
}

struct Args {
    const float* in[13]; float* out; unsigned char* ws;
    double turns[8];
    int ph_lo, ph_hi;
};

__global__ void __launch_bounds__(512, 2) mega_fwd(Args args) {
    extern __shared__ __attribute__((aligned(16))) unsigned char lds[];
    const int tid = threadIdx.x, lane = tid & 63, wave = __builtin_amdgcn_readfirstlane(tid >> 6);
    const int G = gridDim.x, bx = blockIdx.x;
    const int vcu = (G % 8 == 0) ? (bx % 8) * (G / 8) + bx / 8 : bx;
    unsigned char* ws = args.ws;
    const float* x = args.in[0]; const float* norm_w = args.in[1]; const float* w_in = args.in[2]; const float* qnw = args.in[3]; const float* knw = args.in[4];
    const float* lq1 = args.in[5]; const float* lk1 = args.in[6]; const float* lq2 = args.in[7]; const float* lk2 = args.in[8];
    const float* subw = args.in[9]; const float* w_pool = args.in[10]; const float* pscale = args.in[11]; const float* w_out = args.in[12];
    float* ROPE = (float*)(ws + WS_ROPE);
    bf16_t* WPT = (bf16_t*)(ws + WS_WPT); bf16_t* WIT = (bf16_t*)(ws + WS_WIT); bf16_t* WOT = (bf16_t*)(ws + WS_WOT); bf16_t* XS = (bf16_t*)(ws + WS_XS);
    bf16_t* QB = (bf16_t*)(ws + WS_Q); bf16_t* KB = (bf16_t*)(ws + WS_K); bf16_t* VB = (bf16_t*)(ws + WS_V);
    bf16_t* GA = (bf16_t*)(ws + WS_GA); bf16_t* UB = (bf16_t*)(ws + WS_U); bf16_t* GP = (bf16_t*)(ws + WS_GP); bf16_t* MIX = (bf16_t*)(ws + WS_MIX);
    const int lo = args.ph_lo, hi = args.ph_hi;
    volatile LAS unsigned* MISC = (volatile LAS unsigned*)((LAS unsigned char*)lds + 133120);
    if (tid < 2) MISC[tid] = 0u;
    __syncthreads();
    XcdBarrier bar = xcd_barrier_post((unsigned*)(ws + WS_CTL), MISC);
#ifdef ONLY_PHASE
#define IN(k) ((k) == ONLY_PHASE && lo <= (k) && (k) < hi)
#else
#define IN(k) (lo <= (k) && (k) < hi)
#endif
#define SEAM(k) do { if (IN(k) && IN((k) + 1)) { if ((k) == 0) cg::this_grid().sync(); else xcd_barrier(bar); } } while (0)

    if (IN(0)) {
        LAS float* scr = (LAS float*)((LAS unsigned char*)lds + wave * 16384);
        const int gw = vcu * 8 + wave, NGW = G * 8;
        constexpr int I_IN = (DM / 64) * (NIN / 32), I_OUT = (DM / 64) * (DM / 32), I_P = 4 * (256 / 64) * (256 / 32);
        auto decode = [&](int it) -> TItem {
            TItem t; int r = it;
            if (r < I_IN) { const int nblk = NIN / 32, kb = r / nblk, nb = r % nblk, n0 = nb * 32, a = n0 & 255;
                t.W = w_in; t.WT = WIT; t.kscale = norm_w; t.K = DM; t.ldw = LDP; t.N = NIN; t.k0 = kb * 64; t.n0 = n0; t.drow = (n0 & ~255) + ((a >> 5) & 1) * 128 + (a >> 6) * 32; return t; }
            r -= I_IN;
            if (r < I_OUT) { const int nblk = DM / 32, kb = r / nblk, nb = r % nblk;
                t.W = w_out; t.WT = WOT; t.kscale = nullptr; t.K = DM; t.ldw = LDP; t.N = DM; t.k0 = kb * 64; t.n0 = nb * 32; t.drow = nb * 32; return t; }
            r -= I_OUT;
            { const int g = r / 32, rr = r % 32, kb = rr / 8, nb = rr % 8;
              t.W = w_pool + (size_t)g * 65536; t.WT = WPT + (size_t)g * 65536; t.kscale = nullptr; t.K = 256; t.ldw = 256; t.N = 256; t.k0 = kb * 64; t.n0 = nb * 32; t.drow = nb * 32; return t; }
        };
        constexpr int NIT = I_IN + I_OUT + I_P;
        for (int it = gw; it < NIT; it += 2 * NGW) {
            const int it1 = it + NGW; const bool two = it1 < NIT;
            const TItem ta = decode(it), tb = decode(two ? it1 : it);
            float va[32], vb[32];
            titem_load(ta, va, lane);
            if (two) titem_load(tb, vb, lane);
            titem_finish(ta, va, scr, lane);
            if (two) titem_finish(tb, vb, scr, lane);
        }
        for (int m = gw; m < MTOK; m += 2 * NGW) {
            const int m2 = (m + NGW < MTOK) ? m + NGW : m;
            const f32x4* xr0 = (const f32x4*)(x + (size_t)m * DM) + lane; const f32x4* xr1 = (const f32x4*)(x + (size_t)m2 * DM) + lane;
            f32x4 v[8], w2[8]; float s0 = 0.f, s1 = 0.f;
#pragma unroll
            for (int j = 0; j < 8; ++j) { v[j] = xr0[64 * j]; w2[j] = xr1[64 * j]; }
#pragma unroll
            for (int j = 0; j < 8; ++j) { s0 += (v[j].x * v[j].x + v[j].y * v[j].y) + (v[j].z * v[j].z + v[j].w * v[j].w); s1 += (w2[j].x * w2[j].x + w2[j].y * w2[j].y) + (w2[j].z * w2[j].z + w2[j].w * w2[j].w); }
            const float r0 = 1.0f / sqrtf(wave_sum(s0) * (1.0f / DM) + EPSN), r1 = 1.0f / sqrtf(wave_sum(s1) * (1.0f / DM) + EPSN);
            u32x2* o0 = (u32x2*)(XS + (size_t)m * LDP) + lane; u32x2* o1 = (u32x2*)(XS + (size_t)m2 * LDP) + lane;
#pragma unroll
            for (int j = 0; j < 8; ++j) { u32x2 w; w.x = cvtpk(v[j].x * r0, v[j].y * r0); w.y = cvtpk(v[j].z * r0, v[j].w * r0); o0[64 * j] = w;
                                          u32x2 y; y.x = cvtpk(w2[j].x * r1, w2[j].y * r1); y.y = cvtpk(w2[j].z * r1, w2[j].w * r1); o1[64 * j] = y; }
        }
        for (int e = (vcu * 512 + tid); e < SEQ * 8; e += G * 512) {
            const int pos = e >> 3, i = e & 7;
            const double t = (double)pos * args.turns[i];
            const float fr = (float)(t - floor(t));
            ROPE[pos * 16 + i] = __builtin_amdgcn_cosf(fr);
            ROPE[pos * 16 + 8 + i] = __builtin_amdgcn_sinf(fr);
        }
    }
    SEAM(0);

    if (IN(1)) {
        pg8::Gemm g{XS, WIT, MTOK, NIN, DM, LDP}; pg8::StaticOrder S; S.init(MTOK, NIN, G, bx);
        EpiProj E{QB, KB, VB, GA, UB, GP, qnw, knw, ROPE, 0.125f * LOG2E};
        pg8::gemm_phase<EpiProj, pg8::StaticOrder, true, true>((LAS unsigned char*)lds, g, S, E);
    }
    SEAM(1);

    if (IN(2)) {
        const float d1 = wave_sum(lq1[lane] * lk1[lane]), d2 = wave_sum(lq2[lane] * lk2[lane]);
        const float lam = __expf(d1) - __expf(d2) + LAM_INIT;
        const float mq = wave_max(fabsf(qnw[lane])), mk = wave_max(fabsf(knw[lane]));
        const float M2 = 8.0f * mq * mk * LOG2E * 1.02f;
        const float lam_s = __uint_as_float(__builtin_amdgcn_readfirstlane(__float_as_uint(lam)));
        const float nm2_s = __uint_as_float(__builtin_amdgcn_readfirstlane(__float_as_uint(-M2)));
        att::Tensors T{QB, KB, VB, GA, MIX, subw, lam_s, nm2_s};
        for (int u = vcu; u < 256; u += G) { const int bh = u >> 4, qb = u & 15;
            if (nm2_s < -40.0f) att2::unit<true>(bh >> 3, bh & 7, qb, T, (char*)lds); else att2::unit<false>(bh >> 3, bh & 7, qb, T, (char*)lds); }
        for (int blk = vcu; blk < MTOK / 32; blk += G) pool_job(blk, UB, GP, WPT, pscale, MIX, (char*)lds);
    }
    SEAM(2);

    if (IN(3)) {
        pg8::Gemm g{MIX, WOT, MTOK, DM, DM, LDP}; pg8::StaticOrder S; S.init(MTOK, DM, G, bx);
        EpiOut E{x, args.out};
        pg8::gemm_phase<EpiOut, pg8::StaticOrder, true, true>((LAS unsigned char*)lds, g, S, E);
    }
#undef IN
#undef SEAM
}

constexpr int LDS_BYTES = 135168;
extern "C" void kernel_launch(void* const* d_in, const int* in_sizes, int n_in, void* d_out, int out_size, void* d_ws, size_t ws_size, hipStream_t stream) {
    static int grid = 0;
    if (grid == 0) {
        if (n_in != 13 || in_sizes[0] != MTOK * DM || out_size != MTOK * DM || ws_size < WS_END) { fprintf(stderr, "kernel_launch: unexpected shapes\n"); grid = -1; return; }
        int dev = 0, cus = 0, per_cu = 0;
        (void)hipGetDevice(&dev);
        (void)hipDeviceGetAttribute(&cus, hipDeviceAttributeMultiprocessorCount, dev);
        if (hipFuncSetAttribute((const void*)mega_fwd, hipFuncAttributeMaxDynamicSharedMemorySize, LDS_BYTES) != hipSuccess) { fprintf(stderr, "kernel_launch: hipFuncSetAttribute failed\n"); grid = -1; return; }
        if (hipOccupancyMaxActiveBlocksPerMultiprocessor(&per_cu, (const void*)mega_fwd, 512, LDS_BYTES) != hipSuccess || per_cu < 1) { fprintf(stderr, "kernel_launch: occupancy query failed (%d)\n", per_cu); per_cu = 1; }
        (void)hipGetLastError();
        grid = cus * (per_cu > 1 ? 1 : per_cu);
        if (grid > 256) grid = 256;
    }
    if (grid < 0) return;
    Args a{};
    for (int i = 0; i < 13; ++i) a.in[i] = (const float*)d_in[i];
    a.out = (float*)d_out; a.ws = (unsigned char*)d_ws;
    for (int i = 0; i < 8; ++i) a.turns[i] = std::pow(500000.0, -(double)(2 * i) / 16.0) / 6.283185307179586476925;
    constexpr int NL = MK_N_LAUNCHES;
    (void)hipMemsetAsync((char*)d_ws + WS_CTL, 0, CTL_BYTES, stream);
    if (NL == 1) {
        a.ph_lo = 0; a.ph_hi = 4;
        void* kargs[] = {&a};
        hipError_t e = hipLaunchCooperativeKernel((const void*)mega_fwd, dim3(grid), dim3(512), kargs, LDS_BYTES, stream);
        if (e != hipSuccess) fprintf(stderr, "cooperative launch failed: %s (grid %d)\n", hipGetErrorString(e), grid);
        if (PROBE_EXTRA_PHASE >= 0) { a.ph_lo = PROBE_EXTRA_PHASE; a.ph_hi = PROBE_EXTRA_PHASE + 1; hipLaunchKernelGGL(mega_fwd, dim3(grid), dim3(512), LDS_BYTES, stream, a); }
    } else {
        for (int p = 0; p < 4; ++p) { a.ph_lo = p; a.ph_hi = p + 1; hipLaunchKernelGGL(mega_fwd, dim3(grid), dim3(512), LDS_BYTES, stream, a); }
    }
}
```

```cpp
#include <hip/hip_runtime.h>
#include <hip/hip_cooperative_groups.h>
#include <hip/hip_bf16.h>
#include <cstdio>
#include <cstdint>
#include <cmath>
namespace cg = cooperative_groups;

#ifndef PROBE_EXTRA_PHASE
#define PROBE_EXTRA_PHASE -1
#endif
#ifndef MK_N_LAUNCHES
#define MK_N_LAUNCHES 1
#endif

namespace pg8 {
#define PG8_LAS __attribute__((address_space(3)))
typedef unsigned short bf16_t;
typedef short bf16x8 __attribute__((ext_vector_type(8)));
typedef float f32x4 __attribute__((ext_vector_type(4)));
typedef unsigned u32x4 __attribute__((ext_vector_type(4)));
constexpr int BM = 256, BK = 64, HALF = 128, HTB = HALF * BK * 2  , STAGE_BYTES = 8 * HTB, NXCD = 8, WGM = 8;

__host__ __device__ __forceinline__ int lds_byte(int r, int c) { const int st = (r >> 4) * 2 + (c >> 5), rr = r & 15, cc = c & 31, ob = rr * 64 + cc * 2; return st * 1024 + (ob ^ (((ob >> 9) & 1) << 5)); }
__host__ __device__ __forceinline__ void stage_rc(int b, int& R, int& C) { const int st = b / 1024, sb = b % 1024, swz = sb ^ (((sb >> 9) & 1) << 5); R = (st >> 1) * 16 + swz / 64; C = (st & 1) * 32 + (swz % 64) / 2; }
__host__ __device__ __forceinline__ int perm32(int rho) { const int n = rho >> 4, i = rho & 15; return 8 * (i >> 2) + 4 * n + (i & 3); }

struct Unit { int pm, pn; };
struct Gemm { const bf16_t* A; const bf16_t* Bt; int M, N, K, ld; };

struct StaticOrder {
    int nM, nN, nwg, G, c;
    __host__ __device__ void init(int M, int N, int G_, int c_) { nM = M / BM; nN = N / BM; nwg = nM * nN; G = G_; c = c_; }
    __host__ __device__ bool next(int i, Unit& u) const {
        const long L = (long)i * G + c; if (L >= nwg) return false;
        int wgid = (int)L; { const int q = nwg / NXCD, r = nwg % NXCD, xcd = wgid % NXCD, off = wgid / NXCD; wgid = (xcd < r ? xcd * (q + 1) : r * (q + 1) + (xcd - r) * q) + off; }
        const int nig = WGM * nN, gid = wgid / nig, fm = gid * WGM, gsz = (nM - fm) < WGM ? (nM - fm) : WGM;
        u.pm = fm + ((wgid % nig) % gsz); u.pn = (wgid % nig) / gsz; return true;
    }
    __device__ __forceinline__ void a_ready(const Unit&) const {}
    __device__ __forceinline__ void done(const Unit&) const {}
};

__device__ __forceinline__ unsigned cvt_pk_bf16(float lo, float hi) { unsigned r; asm volatile("v_cvt_pk_bf16_f32 %0, %1, %2" : "=v"(r) : "v"(lo), "v"(hi)); return r; }
template <class Epi, class Sched, bool ALIGN_EPI = false, bool SP2 = false>
__device__ __forceinline__ void gemm_phase(PG8_LAS unsigned char* lds, const Gemm g, const Sched& S, const Epi& E) {
    int tid = threadIdx.x; asm volatile("" : "+v"(tid));
    const int wid = __builtin_amdgcn_readfirstlane(tid >> 6), lane = tid & 63, wr = wid >> 2, wc = wid & 3, fr = lane & 15, fq = lane >> 4;
    const int K = g.K, nt = K / BK;
    unsigned voffA[2], voffB[2];
#pragma unroll
    for (int i = 0; i < 2; ++i) { int R, C; stage_rc(tid * 16 + i * 8192, R, C); const int Rb = Epi::PERM ? ((R & ~31) + perm32(R & 31)) : R;
        voffA[i] = (unsigned)(R * g.ld + C) * 2u; voffB[i] = (unsigned)(Rb * g.ld + C) * 2u; }
    const size_t kstep = (size_t)(BK * 2);
    const size_t hstep = (size_t)HALF * g.ld * 2;
    const size_t tstep = 2 * hstep;
    const unsigned ldsw = (unsigned)wid * 1024u;
    const int aoff = lds_byte(wr * 64 + fr, fq * 8), boff = lds_byte(wc * 32 + fr, fq * 8);
#define PG8_SA(b, h) (((b) * 2 + (h)) * HTB)
#define PG8_SB(b, h) ((4 + (b) * 2 + (h)) * HTB)
#define PG8_STAGE(bufoff, gbase, voff) do { _Pragma("unroll") for (int _i = 0; _i < 2; ++_i) \
        __builtin_amdgcn_global_load_lds((const unsigned*)((const char*)(gbase) + (voff)[_i]), (PG8_LAS unsigned*)(lds + (bufoff) + ldsw + _i * 8192), 16, 0, 0); } while (0)
#define PG8_LDA(dst, b, h) do { _Pragma("unroll") for (int m = 0; m < 4; ++m) _Pragma("unroll") for (int k = 0; k < 2; ++k) dst[m][k] = *(const PG8_LAS bf16x8*)(lds + PG8_SA(b, h) + aoff + m * 2048 + k * 1024); } while (0)
#define PG8_LDB(dst, b, h) do { _Pragma("unroll") for (int n = 0; n < 2; ++n) _Pragma("unroll") for (int k = 0; k < 2; ++k) dst[n][k] = *(const PG8_LAS bf16x8*)(lds + PG8_SB(b, h) + boff + n * 2048 + k * 1024); } while (0)
#define PG8_MMA(ai, bj, At, Bt) do { __builtin_amdgcn_s_setprio(1); _Pragma("unroll") for (int m = 0; m < 4; ++m) _Pragma("unroll") for (int n = 0; n < 2; ++n) _Pragma("unroll") for (int k = 0; k < 2; ++k) \
        acc[ai][bj][m][n] = __builtin_amdgcn_mfma_f32_16x16x32_bf16(Bt[n][k], At[m][k], acc[ai][bj][m][n], 0, 0, 0); __builtin_amdgcn_s_setprio(0); } while (0)
#define PG8_WAIT_V(n) asm volatile("s_waitcnt vmcnt(" #n ")" ::: "memory")
#define PG8_WAIT_L(n) asm volatile("s_waitcnt lgkmcnt(" #n ")" ::: "memory")
#define PG8_BAR __builtin_amdgcn_s_barrier()
#define PG8_SCHED __builtin_amdgcn_sched_barrier(0)
    Unit cur, nxt; int ui = 0;
    if (!S.next(0, cur)) return;
    f32x4 acc[2][2][4][2];
    if constexpr (Epi::INIT) E.init(acc, cur, wr, wc, fr, fq);
    else {
#pragma unroll
    for (int a = 0; a < 2; ++a)
#pragma unroll
        for (int b = 0; b < 2; ++b)
#pragma unroll
            for (int m = 0; m < 4; ++m)
#pragma unroll
                for (int n = 0; n < 2; ++n) acc[a][b][m][n] = (f32x4){0.f, 0.f, 0.f, 0.f};
    }
    bf16x8 At[4][2], B0[2][2], B1[2][2];
    const char* cA = (const char*)g.A + (size_t)cur.pm * tstep; const char* cB = (const char*)g.Bt + (size_t)cur.pn * tstep;
    S.a_ready(cur);
    if constexpr (SP2) {
        PG8_STAGE(PG8_SB(0, 0), cB, voffB); PG8_STAGE(PG8_SB(0, 1), cB + hstep, voffB); PG8_STAGE(PG8_SA(0, 0), cA, voffA); PG8_STAGE(PG8_SA(0, 1), cA + hstep, voffA);
        if (wr == 1) PG8_BAR;
        PG8_WAIT_V(2); PG8_BAR;
        PG8_STAGE(PG8_SB(1, 0), cB + kstep, voffB); PG8_STAGE(PG8_SA(1, 0), cA + kstep, voffA); PG8_STAGE(PG8_SB(1, 1), cB + hstep + kstep, voffB);
        PG8_WAIT_V(6); PG8_BAR;
    } else {
        PG8_STAGE(PG8_SB(0, 0), cB, voffB); PG8_STAGE(PG8_SA(0, 0), cA, voffA); PG8_STAGE(PG8_SB(0, 1), cB + hstep, voffB); PG8_STAGE(PG8_SA(0, 1), cA + hstep, voffA);
        if (wr == 1) PG8_BAR;
        PG8_WAIT_V(4); PG8_BAR;
        PG8_STAGE(PG8_SB(1, 0), cB + kstep, voffB); PG8_STAGE(PG8_SA(1, 0), cA + kstep, voffA); PG8_STAGE(PG8_SB(1, 1), cB + hstep + kstep, voffB);
        PG8_WAIT_V(6); PG8_BAR;
    }
    for (;;) {
        const bool has_next = S.next(ui + 1, nxt);
        const char* nA = has_next ? (const char*)g.A + (size_t)nxt.pm * tstep : cA; const char* nB = has_next ? (const char*)g.Bt + (size_t)nxt.pn * tstep : cB;
        for (int t = 0; t < nt; t += 2) {
            const bool last = (t == nt - 2);
            const char* a1 = cA + (size_t)(t + 1) * kstep;
            const char* a2 = last ? nA : cA + (size_t)(t + 2) * kstep; const char* b2 = last ? nB : cB + (size_t)(t + 2) * kstep;
            const char* a3 = a2 + kstep; const char* b3 = b2 + kstep;
            if (last && has_next) S.a_ready(nxt);
            if constexpr (SP2) {
            PG8_LDB(B0, 0, 0); PG8_LDB(B1, 0, 1); PG8_SCHED; PG8_LDA(At, 0, 0); PG8_STAGE(PG8_SA(1, 1), a1 + hstep, voffA);
            PG8_WAIT_V(8); PG8_WAIT_L(0); PG8_BAR; PG8_MMA(0, 0, At, B0); PG8_MMA(0, 1, At, B1); PG8_BAR; PG8_SCHED;
            PG8_LDA(At, 0, 1); PG8_STAGE(PG8_SB(0, 0), b2, voffB); PG8_STAGE(PG8_SB(0, 1), b2 + hstep, voffB); PG8_STAGE(PG8_SA(0, 0), a2, voffA);
            PG8_WAIT_V(8); PG8_WAIT_L(0); PG8_BAR; PG8_MMA(1, 0, At, B0); PG8_MMA(1, 1, At, B1); PG8_BAR; PG8_SCHED;
            PG8_LDB(B0, 1, 0); PG8_LDB(B1, 1, 1); PG8_SCHED; PG8_LDA(At, 1, 0); PG8_STAGE(PG8_SA(0, 1), a2 + hstep, voffA);
            PG8_WAIT_V(8); PG8_WAIT_L(0); PG8_BAR; PG8_MMA(0, 0, At, B0); PG8_MMA(0, 1, At, B1); PG8_BAR; PG8_SCHED;
            PG8_LDA(At, 1, 1); PG8_STAGE(PG8_SB(1, 0), b3, voffB); PG8_STAGE(PG8_SB(1, 1), b3 + hstep, voffB); PG8_STAGE(PG8_SA(1, 0), a3, voffA);
            PG8_WAIT_V(8); PG8_WAIT_L(0); PG8_BAR; PG8_MMA(1, 0, At, B0); PG8_MMA(1, 1, At, B1); PG8_BAR; PG8_SCHED;
            } else {
            PG8_LDB(B0, 0, 0); PG8_SCHED; PG8_LDA(At, 0, 0); PG8_STAGE(PG8_SA(1, 1), a1 + hstep, voffA);
            PG8_WAIT_L(8); PG8_BAR; PG8_WAIT_L(0); PG8_MMA(0, 0, At, B0); PG8_BAR; PG8_SCHED;
            PG8_LDB(B1, 0, 1); PG8_STAGE(PG8_SB(0, 0), b2, voffB);
            PG8_BAR; PG8_WAIT_L(0); PG8_MMA(0, 1, At, B1); PG8_BAR;
            PG8_LDA(At, 0, 1); PG8_STAGE(PG8_SA(0, 0), a2, voffA);
            PG8_BAR; PG8_WAIT_L(0); PG8_MMA(1, 0, At, B0); PG8_BAR; PG8_SCHED;
            PG8_STAGE(PG8_SB(0, 1), b2 + hstep, voffB);
            PG8_WAIT_V(6); PG8_BAR; PG8_MMA(1, 1, At, B1); PG8_BAR;
            PG8_LDB(B0, 1, 0); PG8_SCHED; PG8_LDA(At, 1, 0); PG8_STAGE(PG8_SA(0, 1), a2 + hstep, voffA);
            PG8_WAIT_L(8); PG8_BAR; PG8_WAIT_L(0); PG8_MMA(0, 0, At, B0); PG8_BAR; PG8_SCHED;
            PG8_LDB(B1, 1, 1); PG8_STAGE(PG8_SB(1, 0), b3, voffB);
            PG8_BAR; PG8_WAIT_L(0); PG8_MMA(0, 1, At, B1); PG8_BAR;
            PG8_LDA(At, 1, 1); PG8_STAGE(PG8_SA(1, 0), a3, voffA);
            PG8_BAR; PG8_WAIT_L(0); PG8_MMA(1, 0, At, B0); PG8_BAR; PG8_SCHED;
            PG8_STAGE(PG8_SB(1, 1), b3 + hstep, voffB);
            PG8_WAIT_V(6); PG8_BAR; PG8_MMA(1, 1, At, B1); PG8_BAR;
            }
        }
        if constexpr (ALIGN_EPI) { if (wr == 0) PG8_BAR; }
        if constexpr (!Epi::AFTER_DRAIN) { E(acc, cur, wr, wc, fr, fq); S.done(cur); }
        if (!has_next) break;
        if constexpr (Epi::INIT) E.init(acc, nxt, wr, wc, fr, fq);
        else {
#pragma unroll
        for (int a = 0; a < 2; ++a)
#pragma unroll
            for (int b = 0; b < 2; ++b)
#pragma unroll
                for (int m = 0; m < 4; ++m)
#pragma unroll
                    for (int n = 0; n < 2; ++n) acc[a][b][m][n] = (f32x4){0.f, 0.f, 0.f, 0.f};
        }
        cur = nxt; cA = nA; cB = nB; ++ui;
        if constexpr (ALIGN_EPI) { if (wr == 1) PG8_BAR; }
    }
    PG8_WAIT_V(0);
    if constexpr (!ALIGN_EPI) { if (wr == 0) PG8_BAR; }
    PG8_BAR;
    if constexpr (Epi::AFTER_DRAIN) { E.fused(acc, cur, wr, wc, fr, fq, lds, wid, lane); S.done(cur); }
#undef PG8_SA
#undef PG8_SB
#undef PG8_STAGE
#undef PG8_LDA
#undef PG8_LDB
#undef PG8_MMA
#undef PG8_WAIT_V
#undef PG8_WAIT_L
#undef PG8_BAR
#undef PG8_SCHED
}
}

constexpr int BATCH = 2, SEQ = 4096, DM = 2048, MTOK = BATCH * SEQ;
constexpr int AW = 1024, PW = 1024, NIN = 6144, HD = 64, NH = 8;
constexpr float EPSN = 1e-6f;
constexpr float LAM_INIT = 0.2f;
constexpr float LOG2E = 1.4426950408889634f;

constexpr size_t MiB = 1u << 20;
constexpr size_t WS_ROPE = 0;
constexpr size_t WS_CTL = 512 * 1024, CTL_BYTES = 16384;
constexpr size_t WS_WPT = 1 * MiB;
constexpr int LDP = DM + 64;
constexpr size_t WS_WIT = 2 * MiB;
constexpr size_t WS_WOT = 27 * MiB;
constexpr size_t WS_XS = 36 * MiB;
constexpr size_t WS_Q = 70 * MiB, WS_K = 86 * MiB, WS_V = 102 * MiB, WS_GA = 118 * MiB, WS_U = 134 * MiB, WS_GP = 150 * MiB;
constexpr size_t WS_MIX = 166 * MiB;
constexpr size_t WS_END = 200 * MiB;
static_assert(WS_WIT + (size_t)6144 * LDP * 2 <= WS_WOT && WS_WOT + (size_t)2048 * LDP * 2 <= WS_XS && WS_XS + (size_t)8192 * LDP * 2 <= WS_Q && WS_MIX + (size_t)8192 * LDP * 2 <= WS_END, "d_ws map");

#define LAS __attribute__((address_space(3)))
typedef unsigned short bf16_t;
typedef float f32x4 __attribute__((ext_vector_type(4)));
typedef float f32x2 __attribute__((ext_vector_type(2)));
typedef unsigned u32x4 __attribute__((ext_vector_type(4)));
typedef unsigned u32x2 __attribute__((ext_vector_type(2)));
typedef short bf16x8 __attribute__((ext_vector_type(8)));
typedef short s16x4 __attribute__((ext_vector_type(4)));
typedef float f32x16 __attribute__((ext_vector_type(16)));

typedef __bf16 bf16x2_cv __attribute__((ext_vector_type(2)));
__device__ __forceinline__ unsigned cvtpk(float lo, float hi) { f32x2 v = {lo, hi}; bf16x2_cv b = __builtin_convertvector(v, bf16x2_cv); return __builtin_bit_cast(unsigned, b); }
__device__ __forceinline__ float bf_lo(unsigned w) { return __uint_as_float(w << 16); }
__device__ __forceinline__ float bf_hi(unsigned w) { return __uint_as_float(w & 0xffff0000u); }
__device__ __forceinline__ float silu_f(float x) { return x * __builtin_amdgcn_rcpf(1.0f + __builtin_amdgcn_exp2f(-x * LOG2E)); }
__device__ __forceinline__ float wave_sum(float v) {
#pragma unroll
    for (int o = 1; o < 64; o <<= 1) v += __shfl_xor(v, o);
    return v;
}
__device__ __forceinline__ float wave_max(float v) {
#pragma unroll
    for (int o = 1; o < 64; o <<= 1) v = fmaxf(v, __shfl_xor(v, o));
    return v;
}

struct EpiProj {
    static constexpr bool PERM = true, AFTER_DRAIN = false, INIT = false;
    bf16_t *Q, *K, *V, *GA, *U, *GP; const float *qw, *kw; const float* rope; float qscale;
    __device__ __forceinline__ void operator()(const f32x4 (&acc)[2][2][4][2], const pg8::Unit& u, int wr, int wc, int fr, int fq) const {
        const int type = u.pn >> 2;
        const int col0 = (u.pn & 3) * 256 + wc * 64 + fq * 8;
        const int row0 = u.pm * 256 + wr * 64 + fr;
        if (type <= 1) {
            const float* wsrc = (type == 0 ? qw : kw) + fq * 8;
            const f32x4 w00 = *(const f32x4*)(wsrc), w01 = *(const f32x4*)(wsrc + 4), w10 = *(const f32x4*)(wsrc + 32), w11 = *(const f32x4*)(wsrc + 36);
            bf16_t* dsth = (type == 0 ? Q : K) + (size_t)(((u.pm * 256) >> 12) * NH + (col0 >> 7)) * SEQ * 128 + (col0 & 127);
            const float sc = (type == 0) ? qscale : 1.0f;
            const float sgn = (fq == 0) ? -1.0f : 1.0f;
#pragma unroll
            for (int ai = 0; ai < 2; ++ai) {
                f32x4 rc[4][4];
#pragma unroll
                for (int m = 0; m < 4; ++m) { const float* rp = rope + ((row0 + ai * 128 + m * 16) & (SEQ - 1)) * 16;
#pragma unroll
                    for (int q = 0; q < 4; ++q) rc[m][q] = (fq < 2) ? *(const f32x4*)(rp + 4 * q) : (f32x4){0.f, 0.f, 0.f, 0.f}; }
                asm volatile("" ::: "memory");
#pragma unroll
                for (int m = 0; m < 4; ++m) {
                    const int row = row0 + ai * 128 + m * 16, pos = row & (SEQ - 1);
                    f32x4 v00 = acc[ai][0][m][0], v01 = acc[ai][0][m][1], v10 = acc[ai][1][m][0], v11 = acc[ai][1][m][1];
                    float ss = (v00[0] * v00[0] + v00[1] * v00[1]) + (v00[2] * v00[2] + v00[3] * v00[3]);
                    ss += (v01[0] * v01[0] + v01[1] * v01[1]) + (v01[2] * v01[2] + v01[3] * v01[3]);
                    ss += (v10[0] * v10[0] + v10[1] * v10[1]) + (v10[2] * v10[2] + v10[3] * v10[3]);
                    ss += (v11[0] * v11[0] + v11[1] * v11[1]) + (v11[2] * v11[2] + v11[3] * v11[3]);
                    ss += __shfl_xor(ss, 16); ss += __shfl_xor(ss, 32);
                    const float rs = 1.0f / sqrtf(ss * (1.0f / 64.0f) + EPSN);
                    v00 = v00 * rs * w00; v01 = v01 * rs * w01; v10 = v10 * rs * w10; v11 = v11 * rs * w11;
                    f32x4 o00, o01;
#pragma unroll
                    for (int i = 0; i < 4; ++i) { o00[i] = __shfl_xor(v00[i], 16); o01[i] = __shfl_xor(v01[i], 16); }
                    if (fq < 2) {
                        const f32x4 c0 = rc[m][0], c1 = rc[m][1], s0 = rc[m][2], s1 = rc[m][3];
                        v00 = v00 * c0 + (o00 * s0) * sgn; v01 = v01 * c1 + (o01 * s1) * sgn;
                    }
                    v00 = v00 * sc; v01 = v01 * sc; v10 = v10 * sc; v11 = v11 * sc;
                    u32x4 a, b;
                    a.x = cvtpk(v00[0], v00[1]); a.y = cvtpk(v00[2], v00[3]); a.z = cvtpk(v01[0], v01[1]); a.w = cvtpk(v01[2], v01[3]);
                    b.x = cvtpk(v10[0], v10[1]); b.y = cvtpk(v10[2], v10[3]); b.z = cvtpk(v11[0], v11[1]); b.w = cvtpk(v11[2], v11[3]);
                    bf16_t* rowp = dsth + (size_t)pos * 128;
                    *(u32x4*)(rowp) = a; *(u32x4*)(rowp + 32) = b;
                }
                asm volatile("" ::: "memory");
            }
        } else {
            bf16_t* dst = (type == 2) ? V : (type == 3) ? GA : (type == 4) ? U : GP;
            const bool act = (type == 3) || (type == 5);
            const bool hm = (type == 2);
            const int rstride = hm ? 128 : AW, rmask = hm ? (SEQ - 1) : 0x7fffffff;
            dst += hm ? (size_t)(((u.pm * 256) >> 12) * NH + (col0 >> 7)) * SEQ * 128 + (col0 & 127) : (size_t)col0;
#pragma unroll
            for (int ai = 0; ai < 2; ++ai)
#pragma unroll
                for (int m = 0; m < 4; ++m) {
                    const int row = row0 + ai * 128 + m * 16;
                    bf16_t* rowp = dst + (size_t)(row & rmask) * rstride;
#pragma unroll
                    for (int bj = 0; bj < 2; ++bj) {
                        f32x4 v0 = acc[ai][bj][m][0], v1 = acc[ai][bj][m][1];
                        if (act) {
#pragma unroll
                            for (int i = 0; i < 4; ++i) { v0[i] = silu_f(v0[i]); v1[i] = silu_f(v1[i]); }
                        }
                        u32x4 a; a.x = cvtpk(v0[0], v0[1]); a.y = cvtpk(v0[2], v0[3]); a.z = cvtpk(v1[0], v1[1]); a.w = cvtpk(v1[2], v1[3]);
                        *(u32x4*)(rowp + bj * 32) = a;
                    }
                }
        }
    }
};
struct EpiOut {
    static constexpr bool PERM = true, AFTER_DRAIN = false, INIT = true;
    const float* x; float* out;
    __device__ __forceinline__ void init(f32x4 (&acc)[2][2][4][2], const pg8::Unit& u, int wr, int wc, int fr, int fq) const {
        const int row0 = u.pm * 256 + wr * 64 + fr, col0 = u.pn * 256 + wc * 32 + fq * 8;
#pragma unroll
        for (int ai = 0; ai < 2; ++ai)
#pragma unroll
            for (int m = 0; m < 4; ++m) { const size_t off = (size_t)(row0 + ai * 128 + m * 16) * DM + col0;
#pragma unroll
                for (int bj = 0; bj < 2; ++bj) { acc[ai][bj][m][0] = *(const f32x4*)(x + off + bj * 128); acc[ai][bj][m][1] = *(const f32x4*)(x + off + bj * 128 + 4); } }
    }
    __device__ __forceinline__ void operator()(const f32x4 (&acc)[2][2][4][2], const pg8::Unit& u, int wr, int wc, int fr, int fq) const {
        const int row0 = u.pm * 256 + wr * 64 + fr, col0 = u.pn * 256 + wc * 32 + fq * 8;
#pragma unroll
        for (int ai = 0; ai < 2; ++ai)
#pragma unroll
            for (int m = 0; m < 4; ++m) { const size_t off = (size_t)(row0 + ai * 128 + m * 16) * DM + col0;
#pragma unroll
                for (int bj = 0; bj < 2; ++bj) { *(f32x4*)(out + off + bj * 128) = acc[ai][bj][m][0]; *(f32x4*)(out + off + bj * 128 + 4) = acc[ai][bj][m][1]; } }
    }
};

namespace att {
constexpr int KVBLK = 64, NT = SEQ / KVBLK, LD = 128;
constexpr int SHM_V = KVBLK * 128 * 2, SHM_K = KVBLK * 128 * 2;
constexpr int OFF_V = 0, OFF_K = 2 * SHM_V, OFF_WS = 2 * SHM_V + 2 * SHM_K;
#define KSWZ(row, colB) ((row) * 256 + ((colB) ^ (((row) & 7) << 4)))
#define SBAR() __builtin_amdgcn_sched_barrier(0)
__device__ __forceinline__ int crow(int r, int hi) { return (r & 3) + 8 * (r >> 2) + 4 * hi; }
__device__ __forceinline__ int v_st(int k, int c) { const int kk = (k & ~0xC) | ((k & 4) << 1) | ((k & 8) >> 1); return ((kk >> 3) * 4 + (c >> 5)) * 512 + ((kk & 7) * 32 + (c & 31)) * 2; }
__device__ __forceinline__ int v_rd_base(int lane) { return ((lane & 3) << 3) | (((lane >> 2) & 3) << 6) | (((lane >> 4) & 1) << 5) | (((lane >> 5) & 1) << 8); }
constexpr int v_rd_off(int d0, int ks, int half) { return d0 * 512 + ks * 4096 + half * 2048; }
template <int OFF> __device__ __forceinline__ s16x4 tr_read(int vb) {
    s16x4 r; asm volatile("ds_read_b64_tr_b16 %0, %1 offset:%2" : "=&v"(r) : "v"(vb), "i"(OFF) : "memory"); return r;
}
template <int D0> __device__ __forceinline__ void pv_one(f32x16& od, int vb, bf16x8 pa0, bf16x8 pa1, bf16x8 pa2, bf16x8 pa3) {
    const s16x4 l0 = tr_read<v_rd_off(D0, 0, 0)>(vb), h0 = tr_read<v_rd_off(D0, 0, 1)>(vb), l1 = tr_read<v_rd_off(D0, 1, 0)>(vb), h1 = tr_read<v_rd_off(D0, 1, 1)>(vb);
    const s16x4 l2 = tr_read<v_rd_off(D0, 2, 0)>(vb), h2 = tr_read<v_rd_off(D0, 2, 1)>(vb), l3 = tr_read<v_rd_off(D0, 3, 0)>(vb), h3 = tr_read<v_rd_off(D0, 3, 1)>(vb);
    asm volatile("s_waitcnt lgkmcnt(0)" ::: "memory"); SBAR();
#define PK(L, H) (bf16x8){L[0], L[1], L[2], L[3], H[0], H[1], H[2], H[3]}
    od = __builtin_amdgcn_mfma_f32_32x32x16_bf16(pa0, PK(l0, h0), od, 0, 0, 0);
    od = __builtin_amdgcn_mfma_f32_32x32x16_bf16(pa1, PK(l1, h1), od, 0, 0, 0);
    od = __builtin_amdgcn_mfma_f32_32x32x16_bf16(pa2, PK(l2, h2), od, 0, 0, 0);
    od = __builtin_amdgcn_mfma_f32_32x32x16_bf16(pa3, PK(l3, h3), od, 0, 0, 0);
#undef PK
}
__device__ __forceinline__ void pv_d0(f32x16* o, int vb, bf16x8 pa0, bf16x8 pa1, bf16x8 pa2, bf16x8 pa3) {
    pv_one<0>(o[0], vb, pa0, pa1, pa2, pa3); pv_one<1>(o[1], vb, pa0, pa1, pa2, pa3); pv_one<2>(o[2], vb, pa0, pa1, pa2, pa3); pv_one<3>(o[3], vb, pa0, pa1, pa2, pa3);
}
__device__ __forceinline__ void qkt(f32x16& p0, f32x16& p1, const char* Ks, const bf16x8* qr, int comp, int r32, int hi) {
    const f32x16 zero = f32x16{};
#pragma unroll
    for (int d = 0; d < 4; ++d) { const int cb = ((comp * 4 + d) * 16 + hi * 8) * 2;
        const bf16x8 b0 = *reinterpret_cast<const bf16x8*>(Ks + KSWZ(r32, cb));
        const bf16x8 b1 = *reinterpret_cast<const bf16x8*>(Ks + KSWZ(32 + r32, cb));
        if (d == 0) { p0 = __builtin_amdgcn_mfma_f32_32x32x16_bf16(b0, qr[0], zero, 0, 0, 0); p1 = __builtin_amdgcn_mfma_f32_32x32x16_bf16(b1, qr[0], zero, 0, 0, 0); }
        else { p0 = __builtin_amdgcn_mfma_f32_32x32x16_bf16(b0, qr[d], p0, 0, 0, 0); p1 = __builtin_amdgcn_mfma_f32_32x32x16_bf16(b1, qr[d], p1, 0, 0, 0); } }
}
template <bool SHIFT> __device__ __forceinline__ void partialSM(f32x16& p0, float negM2) {
#pragma unroll
    for (int r = 0; r < 16; ++r) p0[r] = __builtin_amdgcn_exp2f(SHIFT ? p0[r] + negM2 : p0[r]);
}
template <bool SHIFT> __device__ __forceinline__ void finishSM(f32x16& p0, f32x16& p1, float negM2, float& l_reg, bf16x8& pa0, bf16x8& pa1, bf16x8& pa2, bf16x8& pa3) {
#pragma unroll
    for (int r = 0; r < 16; ++r) p1[r] = __builtin_amdgcn_exp2f(SHIFT ? p1[r] + negM2 : p1[r]);
    float ps = 0.f;
#pragma unroll
    for (int r = 0; r < 16; ++r) ps += p0[r];
#pragma unroll
    for (int r = 0; r < 16; ++r) ps += p1[r];
    l_reg += ps;
#define PK4(P, BASE, OUT) do { unsigned a0 = cvtpk(P[BASE + 0], P[BASE + 1]), a1 = cvtpk(P[BASE + 2], P[BASE + 3]);   \
    unsigned b0 = cvtpk(P[BASE + 4], P[BASE + 5]), b1 = cvtpk(P[BASE + 6], P[BASE + 7]);                              \
    auto r0 = __builtin_amdgcn_permlane32_swap(a0, b0, false, false); auto r1 = __builtin_amdgcn_permlane32_swap(a1, b1, false, false); \
    u32x4 w = {r0[0], r1[0], r0[1], r1[1]}; OUT = *reinterpret_cast<bf16x8*>(&w); } while (0)
    PK4(p0, 0, pa0); PK4(p0, 8, pa1); PK4(p1, 0, pa2); PK4(p1, 8, pa3);
#undef PK4
}

struct Tensors { const bf16_t *Q, *K, *V, *GA; bf16_t* MIX; const float* subw; float lam, negM2; };
__device__ __forceinline__ void epilogue(f32x16 (&o)[4], float l_reg, int b, int h, int qb, const Tensors& T, char* lds);

template <bool SHIFT> __device__ __forceinline__ void unit(int b, int h, int qb, const Tensors& T, char* lds) {
    const float negM2 = T.negM2;
    int tid = threadIdx.x; asm volatile("" : "+v"(tid));
    const int wid = __builtin_amdgcn_readfirstlane(tid >> 6), lane = tid & 63, r32 = lane & 31, hi = lane >> 5;
    const int comp = wid >> 2, rw = wid & 3;
    char* V_lds = lds + OFF_V; char* K_lds = lds + OFF_K;
    float* wsf = (float*)(lds + OFF_WS) + wid * 64;
    const long rowbase = (long)b * SEQ; const int q0 = qb * 128;
    const long hb = (long)(b * NH + h) * SEQ;
    const bf16_t* Kh = T.K + hb * LD; const bf16_t* Vh = T.V + hb * LD;
    bf16x8 qr[4];
    { const bf16_t* Qw = T.Q + (hb + q0 + rw * 32 + r32) * LD + comp * 64 + hi * 8;
#pragma unroll
      for (int d = 0; d < 4; ++d) qr[d] = *reinterpret_cast<const bf16x8*>(Qw + d * 16); }
    float l_reg = 0.f; f32x16 o[4];
#pragma unroll
    for (int d = 0; d < 4; ++d) o[d] = f32x16{};
    const int sr = tid >> 4, sc = (tid & 15) * 8, vst0 = v_st(sr, sc), vst1 = v_st(32 + sr, sc);
    const int vb0 = (int)(uintptr_t)V_lds + v_rd_base(lane);
    struct { bf16x8 vs0, vs1, ks0, ks1; } sr_[2];
#define LD8(p) (*reinterpret_cast<const bf16x8*>(p))
#define SLOAD(i, k0) do { sr_[i].vs0 = LD8(&Vh[(long)((k0) + sr) * LD + sc]); sr_[i].vs1 = LD8(&Vh[(long)((k0) + 32 + sr) * LD + sc]); \
    sr_[i].ks0 = LD8(&Kh[(long)((k0) + sr) * LD + sc]); sr_[i].ks1 = LD8(&Kh[(long)((k0) + 32 + sr) * LD + sc]); } while (0)
#define SWRITE(bb, i) do { *(bf16x8*)(V_lds + (bb) * SHM_V + vst0) = sr_[i].vs0;          \
    *(bf16x8*)(V_lds + (bb) * SHM_V + vst1) = sr_[i].vs1; const int kc = sc * 2;               \
    *(bf16x8*)(K_lds + (bb) * SHM_K + KSWZ(sr, kc)) = sr_[i].ks0;                       \
    *(bf16x8*)(K_lds + (bb) * SHM_K + KSWZ(32 + sr, kc)) = sr_[i].ks1; } while (0)
#define SWAIT() asm volatile("s_waitcnt vmcnt(4)" ::: "memory")
    f32x16 pA0, pA1, pB0, pB1; bf16x8 pa0, pa1, pa2, pa3;
    constexpr int SE = 0, SO = 1;
    SLOAD(SE, 0); asm volatile("s_waitcnt vmcnt(0)" ::: "memory"); SWRITE(0, SE); __syncthreads();
    qkt(pA0, pA1, K_lds, qr, comp, r32, hi); partialSM<SHIFT>(pA0, negM2);
    SLOAD(SO, KVBLK); SLOAD(SE, 2 * KVBLK);
    SWAIT(); SWRITE(1, SO); __syncthreads();
#pragma unroll 1
    for (int j = 1; j + 1 < NT; j += 2) {
        SBAR(); qkt(pB0, pB1, K_lds + SHM_K, qr, comp, r32, hi);
        finishSM<SHIFT>(pA0, pA1, negM2, l_reg, pa0, pa1, pa2, pa3); SBAR();
        SLOAD(SO, (j + 2) * KVBLK); SBAR();
        pv_d0(o, vb0, pa0, pa1, pa2, pa3); partialSM<SHIFT>(pB0, negM2);
        __syncthreads(); SWAIT(); SWRITE(0, SE);
        __syncthreads();
        SBAR(); qkt(pA0, pA1, K_lds, qr, comp, r32, hi);
        finishSM<SHIFT>(pB0, pB1, negM2, l_reg, pa0, pa1, pa2, pa3); SBAR();
        SLOAD(SE, (j + 3 < NT ? j + 3 : NT - 1) * KVBLK); SBAR();
        pv_d0(o, vb0 + SHM_V, pa0, pa1, pa2, pa3); partialSM<SHIFT>(pA0, negM2);
        __syncthreads(); SWAIT(); SWRITE(1, SO);
        __syncthreads();
    }
    SBAR(); qkt(pB0, pB1, K_lds + SHM_K, qr, comp, r32, hi);
    finishSM<SHIFT>(pA0, pA1, negM2, l_reg, pa0, pa1, pa2, pa3); SBAR();
    pv_d0(o, vb0, pa0, pa1, pa2, pa3); partialSM<SHIFT>(pB0, negM2);
    finishSM<SHIFT>(pB0, pB1, negM2, l_reg, pa0, pa1, pa2, pa3); SBAR();
    pv_d0(o, vb0 + SHM_V, pa0, pa1, pa2, pa3);
#undef SLOAD
#undef SWRITE
#undef SWAIT
#undef LD8
    epilogue(o, l_reg, b, h, qb, T, lds);
}
__device__ __forceinline__ void epilogue(f32x16 (&o)[4], float l_reg, int b, int h, int qb, const Tensors& T, char* lds) {
    int tid = threadIdx.x; asm volatile("" : "+v"(tid));
    const int wid = __builtin_amdgcn_readfirstlane(tid >> 6), lane = tid & 63, r32 = lane & 31, hi = lane >> 5;
    const int comp = wid >> 2, rw = wid & 3;
    float* wsf = (float*)(lds + OFF_WS) + wid * 64;
    const long rowbase = (long)b * SEQ; const int q0 = qb * 128;
    { auto rr = __builtin_amdgcn_permlane32_swap(__float_as_uint(l_reg), __float_as_uint(l_reg), false, false); l_reg = __uint_as_float(rr[0]) + __uint_as_float(rr[1]); }
    if (hi == 0) wsf[r32] = l_reg;
    asm volatile("s_waitcnt lgkmcnt(0)" ::: "memory");
    float rli[16];
#pragma unroll
    for (int r = 0; r < 16; ++r) rli[r] = __builtin_amdgcn_rcpf(wsf[crow(r, hi)]);
    __syncthreads();
    float* X = (float*)lds + rw * 4096;
    if (comp == 1) {
        const float lam = T.lam;
#pragma unroll
        for (int r = 0; r < 16; ++r) { const float f = rli[r] * lam;
#pragma unroll
            for (int d = 0; d < 4; ++d) X[crow(r, hi) * 128 + d * 32 + r32] = o[d][r] * f; }
    }
    __syncthreads();
    if (comp == 0) {
        float sw[4];
#pragma unroll
        for (int d = 0; d < 4; ++d) sw[d] = T.subw[d * 32 + r32] * (1.0f - LAM_INIT);
#pragma unroll
        for (int r = 0; r < 16; ++r) {
            float a[4]; float ss = 0.f;
#pragma unroll
            for (int d = 0; d < 4; ++d) { a[d] = o[d][r] * rli[r] - X[crow(r, hi) * 128 + d * 32 + r32]; ss += a[d] * a[d]; }
            ss += __shfl_xor(ss, 1); ss += __shfl_xor(ss, 2); ss += __shfl_xor(ss, 4); ss += __shfl_xor(ss, 8); ss += __shfl_xor(ss, 16);
            const float rs = 1.0f / sqrtf(ss * (1.0f / 128.0f) + EPSN);
#pragma unroll
            for (int d = 0; d < 4; ++d) X[crow(r, hi) * 128 + d * 32 + r32] = a[d] * rs * sw[d];
        }
    }
    __syncthreads();
#pragma unroll
    for (int i = 0; i < 4; ++i) {
        const int idx = i * 64 + lane, row = comp * 16 + (idx >> 4), ch = idx & 15;
        const f32x4 z0 = *(const f32x4*)(X + row * 128 + ch * 8), z1 = *(const f32x4*)(X + row * 128 + ch * 8 + 4);
        const long grow = rowbase + q0 + rw * 32 + row;
        const u32x4 g = *(const u32x4*)(T.GA + grow * AW + h * 128 + ch * 8);
        u32x4 w;
        w.x = cvtpk(z0[0] * bf_lo(g.x), z0[1] * bf_hi(g.x)); w.y = cvtpk(z0[2] * bf_lo(g.y), z0[3] * bf_hi(g.y));
        w.z = cvtpk(z1[0] * bf_lo(g.z), z1[1] * bf_hi(g.z)); w.w = cvtpk(z1[2] * bf_lo(g.w), z1[3] * bf_hi(g.w));
        *(u32x4*)(T.MIX + grow * DM + h * 128 + ch * 8) = w;
    }
    __syncthreads();
}
}


namespace att2 {
#ifndef DEBUG_SYNC_COPY
#define DEBUG_SYNC_COPY 0
#endif
using att::crow; using att::Tensors; using att::tr_read; using att::v_rd_off; using att::v_rd_base;
constexpr int NT = SEQ / 64, SHM = 16384;
constexpr int OFF_Q = 0, OFF_V = 65536, OFF_K = 98304, OFF_WS = 131072;
typedef LAS unsigned char* ldsp;
__device__ __forceinline__ void glds16s(unsigned voff, const void* sbase, unsigned lds_dst) { unsigned keep;
    asm volatile("s_mov_b32 %0, m0\n\ts_mov_b32 m0, %3\n\ts_nop 0\n\tglobal_load_lds_dwordx4 %1, %2\n\ts_mov_b32 m0, %0" : "=&s"(keep) : "v"(voff), "s"(sbase), "s"(lds_dst) : "memory"); }
typedef __bf16 bf16x2_t __attribute__((ext_vector_type(2)));
__device__ __forceinline__ unsigned cvtpk_s(float lo, float hi) { f32x2 v = {lo, hi}; bf16x2_t b = __builtin_convertvector(v, bf16x2_t); return __builtin_bit_cast(unsigned, b); }
template <int H, int D0> __device__ __forceinline__ void v_rd4(s16x4 (&f)[4], int vb) {
    f[0] = tr_read<v_rd_off(D0, 2 * H, 0)>(vb); f[1] = tr_read<v_rd_off(D0, 2 * H, 1)>(vb); f[2] = tr_read<v_rd_off(D0, 2 * H + 1, 0)>(vb); f[3] = tr_read<v_rd_off(D0, 2 * H + 1, 1)>(vb);
}
__device__ __forceinline__ void pv_mma(f32x16& oa, f32x16& ob, const s16x4 (&f)[4], const bf16x8 (&pa)[2], const bf16x8 (&pb)[2]) {
#define PK(L, H_) (bf16x8){L[0], L[1], L[2], L[3], H_[0], H_[1], H_[2], H_[3]}
    const bf16x8 v0 = PK(f[0], f[1]), v1 = PK(f[2], f[3]);
#undef PK
    oa = __builtin_amdgcn_mfma_f32_32x32x16_bf16(pa[0], v0, oa, 0, 0, 0);
    ob = __builtin_amdgcn_mfma_f32_32x32x16_bf16(pb[0], v0, ob, 0, 0, 0);
    oa = __builtin_amdgcn_mfma_f32_32x32x16_bf16(pa[1], v1, oa, 0, 0, 0);
    ob = __builtin_amdgcn_mfma_f32_32x32x16_bf16(pb[1], v1, ob, 0, 0, 0);
}
template <int H> __device__ __forceinline__ void pv_half(f32x16 (&o0)[4], f32x16 (&o1)[4], int vb, const bf16x8 (&pa)[2], const bf16x8 (&pb)[2]) {
    s16x4 fa[4], fb[4];
    SBAR();
    v_rd4<H, 0>(fa, vb); v_rd4<H, 1>(fb, vb);
    asm volatile("s_waitcnt lgkmcnt(4)" ::: "memory"); SBAR();
    pv_mma(o0[0], o1[0], fa, pa, pb); SBAR();
    v_rd4<H, 2>(fa, vb);
    asm volatile("s_waitcnt lgkmcnt(4)" ::: "memory"); SBAR();
    pv_mma(o0[1], o1[1], fb, pa, pb); SBAR();
    v_rd4<H, 3>(fb, vb);
    asm volatile("s_waitcnt lgkmcnt(4)" ::: "memory"); SBAR();
    pv_mma(o0[2], o1[2], fa, pa, pb); SBAR();
    asm volatile("s_waitcnt lgkmcnt(0)" ::: "memory"); SBAR();
    pv_mma(o0[3], o1[3], fb, pa, pb); SBAR();
}
template <int C, int H> __device__ __forceinline__ void qkt_half(f32x16& p, ldsp Kb, ldsp Qw, const int (&fa)[4]) {
    const f32x16 zero = f32x16{};
#pragma unroll
    for (int d = 0; d < 4; ++d) {
        const bf16x8 q = *(const LAS bf16x8*)(Qw + fa[d] + C * 128);
        const bf16x8 kf = *(const LAS bf16x8*)(Kb + fa[d] + C * 128 + H * 8192);
        if (d == 0) p = __builtin_amdgcn_mfma_f32_32x32x16_bf16(kf, q, zero, 0, 0, 0);
        else p = __builtin_amdgcn_mfma_f32_32x32x16_bf16(kf, q, p, 0, 0, 0); }
}
template <int C, int H> __device__ __forceinline__ void qkt_half_r(f32x16& p, ldsp Kb, const bf16x8 (&qa)[4], const int (&fa)[4]) {
    const f32x16 zero = f32x16{};
#pragma unroll
    for (int d = 0; d < 4; ++d) {
        const bf16x8 kf = *(const LAS bf16x8*)(Kb + fa[d] + C * 128 + H * 8192);
        if (d == 0) p = __builtin_amdgcn_mfma_f32_32x32x16_bf16(kf, qa[0], zero, 0, 0, 0);
        else p = __builtin_amdgcn_mfma_f32_32x32x16_bf16(kf, qa[d], p, 0, 0, 0); }
}
template <bool SHIFT> __device__ __forceinline__ void softmax_half(f32x16& p, float negM2, float& l_reg, bf16x8 (&pa)[2]) {
#pragma unroll
    for (int r = 0; r < 16; ++r) p[r] = __builtin_amdgcn_exp2f(SHIFT ? p[r] + negM2 : p[r]);
#pragma unroll
    for (int r = 0; r < 16; ++r) l_reg += p[r];
#define PK4(P, BASE, OUT) do { unsigned a0 = cvtpk_s(P[BASE + 0], P[BASE + 1]), a1 = cvtpk_s(P[BASE + 2], P[BASE + 3]);   \
    unsigned b0 = cvtpk_s(P[BASE + 4], P[BASE + 5]), b1 = cvtpk_s(P[BASE + 6], P[BASE + 7]);                              \
    auto r0 = __builtin_amdgcn_permlane32_swap(a0, b0, false, false); auto r1 = __builtin_amdgcn_permlane32_swap(a1, b1, false, false); \
    u32x4 w = {r0[0], r1[0], r0[1], r1[1]}; OUT = *reinterpret_cast<bf16x8*>(&w); } while (0)
    PK4(p, 0, pa[0]); PK4(p, 8, pa[1]);
#undef PK4
}
template <bool SHIFT, int H, class Mid> __device__ __forceinline__ void half_tile(ldsp Kb, int vb, ldsp Qw, const int (&fa)[4], const bf16x8 (&qa)[4], const bf16x8 (&qb_)[4], float negM2, f32x16 (&o0)[4], f32x16 (&o1)[4], float& l0, float& l1, Mid&& mid) {
    f32x16 sa, sb; bf16x8 pa[2], pb[2];
    asm volatile("" : "+v"(l0) : "v"(l1));
    qkt_half_r<0, H>(sa, Kb, qa, fa);
    qkt_half_r<1, H>(sb, Kb, qb_, fa);
    if (H == 1) {
#pragma unroll
        for (int i = 0; i < 8; ++i) { __builtin_amdgcn_sched_group_barrier(0x008, 1, 0); __builtin_amdgcn_sched_group_barrier(0x100, 2, 0); }
    }
    softmax_half<SHIFT>(sa, negM2, l0, pa);
    asm volatile("" : "+v"(l1) : "v"(l0));
    SBAR();
    s16x4 f0[4], f1[4], f2[4], f3[4];
    v_rd4<H, 0>(f0, vb); v_rd4<H, 1>(f1, vb); v_rd4<H, 2>(f2, vb); v_rd4<H, 3>(f3, vb);
    asm volatile("s_waitcnt lgkmcnt(0)" ::: "memory"); SBAR();
    mid();
    SBAR();
#define PK(L, H_) (bf16x8){L[0], L[1], L[2], L[3], H_[0], H_[1], H_[2], H_[3]}
    const bf16x8 v00 = PK(f0[0], f0[1]), v01 = PK(f0[2], f0[3]), v10 = PK(f1[0], f1[1]), v11 = PK(f1[2], f1[3]);
    const bf16x8 v20 = PK(f2[0], f2[1]), v21 = PK(f2[2], f2[3]), v30 = PK(f3[0], f3[1]), v31 = PK(f3[2], f3[3]);
#undef PK
    o0[0] = __builtin_amdgcn_mfma_f32_32x32x16_bf16(pa[0], v00, o0[0], 0, 0, 0);
    o0[1] = __builtin_amdgcn_mfma_f32_32x32x16_bf16(pa[0], v10, o0[1], 0, 0, 0);
    o0[2] = __builtin_amdgcn_mfma_f32_32x32x16_bf16(pa[0], v20, o0[2], 0, 0, 0);
    o0[3] = __builtin_amdgcn_mfma_f32_32x32x16_bf16(pa[0], v30, o0[3], 0, 0, 0);
    o0[0] = __builtin_amdgcn_mfma_f32_32x32x16_bf16(pa[1], v01, o0[0], 0, 0, 0);
    o0[1] = __builtin_amdgcn_mfma_f32_32x32x16_bf16(pa[1], v11, o0[1], 0, 0, 0);
    o0[2] = __builtin_amdgcn_mfma_f32_32x32x16_bf16(pa[1], v21, o0[2], 0, 0, 0);
    o0[3] = __builtin_amdgcn_mfma_f32_32x32x16_bf16(pa[1], v31, o0[3], 0, 0, 0);
    softmax_half<SHIFT>(sb, negM2, l1, pb);
#pragma unroll
    for (int i = 0; i < 8; ++i) { __builtin_amdgcn_sched_group_barrier(0x008, 1, 0); __builtin_amdgcn_sched_group_barrier(0x402, 6, 0); }
    o1[0] = __builtin_amdgcn_mfma_f32_32x32x16_bf16(pb[0], v00, o1[0], 0, 0, 0);
    o1[1] = __builtin_amdgcn_mfma_f32_32x32x16_bf16(pb[0], v10, o1[1], 0, 0, 0);
    o1[2] = __builtin_amdgcn_mfma_f32_32x32x16_bf16(pb[0], v20, o1[2], 0, 0, 0);
    o1[3] = __builtin_amdgcn_mfma_f32_32x32x16_bf16(pb[0], v30, o1[3], 0, 0, 0);
    o1[0] = __builtin_amdgcn_mfma_f32_32x32x16_bf16(pb[1], v01, o1[0], 0, 0, 0);
    o1[1] = __builtin_amdgcn_mfma_f32_32x32x16_bf16(pb[1], v11, o1[1], 0, 0, 0);
    o1[2] = __builtin_amdgcn_mfma_f32_32x32x16_bf16(pb[1], v21, o1[2], 0, 0, 0);
    o1[3] = __builtin_amdgcn_mfma_f32_32x32x16_bf16(pb[1], v31, o1[3], 0, 0, 0);
}
template <bool SHIFT, class Mid> __device__ __forceinline__ void tile(ldsp Kb, int vb, ldsp Qw, const int (&fa)[4], const bf16x8 (&qa)[4], const bf16x8 (&qb_)[4], float negM2, f32x16 (&o0)[4], f32x16 (&o1)[4], float& l0, float& l1, Mid&& mid) {
    half_tile<SHIFT, 0>(Kb, vb, Qw, fa, qa, qb_, negM2, o0, o1, l0, l1, [] {});
    half_tile<SHIFT, 1>(Kb, vb, Qw, fa, qa, qb_, negM2, o0, o1, l0, l1, mid);
}
__device__ __forceinline__ void epilogue2(f32x16 (&o0)[4], f32x16 (&o1)[4], float l0, float l1, int b, int h, int qb, const Tensors& T, char* lds);

template <bool SHIFT> __device__ __forceinline__ void unit(int b, int h, int qb, const Tensors& T, char* ldsc) {
    int tid = threadIdx.x; asm volatile("" : "+v"(tid));
    const int wid = __builtin_amdgcn_readfirstlane(tid >> 6), lane = tid & 63, r32 = lane & 31, hi = lane >> 5;
    ldsp lds = (ldsp)ldsc;
    const long hb = (long)(b * NH + h) * SEQ;
    const bf16_t* Kh = T.K + hb * 128; const bf16_t* Vh = T.V + hb * 128;
    const unsigned lds0 = (unsigned)(uintptr_t)ldsc;
    const unsigned kdst = lds0 + OFF_K + wid * 2048, vdst = lds0 + OFF_V + wid * 2048;
    unsigned dko[2], dvo[2];
#pragma unroll
    for (int i_ = 0; i_ < 2; ++i_) { const int c_ = wid * 2 + i_;
        const int row_ = 4 * c_ + (lane >> 4), pc_ = lane & 15; dko[i_] = (unsigned)(row_ * 128 + ((pc_ ^ (row_ & 7)) * 8)) * 2u;
        const int s_ = 2 * c_ + (lane >> 5), kk_ = (s_ >> 2) * 8 + ((lane & 31) >> 2), col_ = (s_ & 3) * 32 + (lane & 3) * 8;
        const int k_ = (kk_ & ~0xC) | ((kk_ & 4) << 1) | ((kk_ & 8) >> 1); dvo[i_] = (unsigned)(k_ * 128 + col_) * 2u; }
#define DMA_TILE(t, buf) do { const char* kt_ = (const char*)Kh + (size_t)(t) * 16384; const char* vt_ = (const char*)Vh + (size_t)(t) * 16384; \
        glds16s(dko[0], kt_, kdst + (buf) * SHM); glds16s(dvo[0], vt_, vdst + (buf) * SHM); \
        glds16s(dko[1], kt_, kdst + (buf) * SHM + 1024); glds16s(dvo[1], vt_, vdst + (buf) * SHM + 1024); } while (0)
    DMA_TILE(0, 0);
    ldsp Qw = lds + OFF_Q + wid * 8192;
    { const bf16_t* Qg = T.Q + (hb + qb * 256 + wid * 32) * 128;
      bf16x8 qv[8];
#pragma unroll
      for (int i = 0; i < 8; ++i) qv[i] = *reinterpret_cast<const bf16x8*>(Qg + (i * 4 + (lane >> 4)) * 128 + (lane & 15) * 8);
#pragma unroll
      for (int i = 0; i < 8; ++i) { const int row = i * 4 + (lane >> 4); *(LAS bf16x8*)(Qw + row * 256 + (((lane & 15) * 16) ^ ((row & 7) << 4))) = qv[i]; } }
    const float negM2 = T.negM2;
    float l0 = 0.f, l1 = 0.f; f32x16 o0[4], o1[4];
#pragma unroll
    for (int d = 0; d < 4; ++d) { o0[d] = f32x16{}; o1[d] = f32x16{}; }
    const int vb0 = (int)(uintptr_t)(lds + OFF_V) + v_rd_base(lane);
    int fa[4];
#pragma unroll
    for (int d = 0; d < 4; ++d) fa[d] = r32 * 256 + ((d * 32 + hi * 16) ^ ((r32 & 7) << 4));
#define OPEN_TILE() do { asm volatile("s_waitcnt vmcnt(0) lgkmcnt(0)" ::: "memory"); __builtin_amdgcn_s_barrier(); asm volatile("" ::: "memory"); } while (0)
    OPEN_TILE(); DMA_TILE(1, 1);
    if (wid >= 4) __builtin_amdgcn_s_setprio(1);
    bf16x8 qa[4], qb_[4];
#pragma unroll
    for (int d = 0; d < 4; ++d) { qa[d] = *(const LAS bf16x8*)(Qw + fa[d]); qb_[d] = *(const LAS bf16x8*)(Qw + fa[d] + 128); }
#pragma unroll 1
    for (int t = 0; t < NT; t += 2) {
        tile<SHIFT>(lds + OFF_K, vb0, Qw, fa, qa, qb_, negM2, o0, o1, l0, l1, [&] { OPEN_TILE(); DMA_TILE((t + 2 < NT ? t + 2 : NT - 1), 0); });
        tile<SHIFT>(lds + OFF_K + SHM, vb0 + SHM, Qw, fa, qa, qb_, negM2, o0, o1, l0, l1, [&] { OPEN_TILE(); DMA_TILE((t + 3 < NT ? t + 3 : NT - 1), 1); });
    }
#undef DMA_TILE
#undef OPEN_TILE
    __builtin_amdgcn_s_setprio(0);
    asm volatile("s_waitcnt vmcnt(0) lgkmcnt(0)" ::: "memory"); __builtin_amdgcn_s_barrier(); asm volatile("" ::: "memory");
    epilogue2(o0, o1, l0, l1, b, h, qb, T, ldsc);
}
__device__ __forceinline__ void epilogue2(f32x16 (&o0)[4], f32x16 (&o1)[4], float l0, float l1, int b, int h, int qb, const Tensors& T, char* lds) {
    int tid = threadIdx.x; asm volatile("" : "+v"(tid));
    const int wid = __builtin_amdgcn_readfirstlane(tid >> 6), lane = tid & 63, r32 = lane & 31, hi = lane >> 5;
    float* wsf = (float*)(lds + OFF_WS) + wid * 64;
    { auto rr = __builtin_amdgcn_permlane32_swap(__float_as_uint(l0), __float_as_uint(l0), false, false); l0 = __uint_as_float(rr[0]) + __uint_as_float(rr[1]); }
    { auto rr = __builtin_amdgcn_permlane32_swap(__float_as_uint(l1), __float_as_uint(l1), false, false); l1 = __uint_as_float(rr[0]) + __uint_as_float(rr[1]); }
    if (hi == 0) { wsf[r32] = l0; wsf[32 + r32] = l1; }
    asm volatile("s_waitcnt lgkmcnt(0)" ::: "memory");
    float* X = (float*)(lds + wid * 16384);
    float sw[4];
#pragma unroll
    for (int d = 0; d < 4; ++d) sw[d] = T.subw[d * 32 + r32] * (1.0f - LAM_INIT);
    const float lam = T.lam;
#pragma unroll
    for (int r = 0; r < 16; ++r) {
        const int row = crow(r, hi);
        const float f1 = lam * __builtin_amdgcn_rcpf(wsf[32 + row]);
#pragma unroll
        for (int d = 0; d < 4; ++d) X[row * 128 + d * 32 + r32] = o1[d][r] * f1;
    }
    asm volatile("s_waitcnt lgkmcnt(0)" ::: "memory"); SBAR();
#pragma unroll
    for (int r = 0; r < 16; ++r) {
        const int row = crow(r, hi);
        const float f0 = __builtin_amdgcn_rcpf(wsf[row]);
        float a[4]; float ss = 0.f;
#pragma unroll
        for (int d = 0; d < 4; ++d) { a[d] = o0[d][r] * f0 - X[row * 128 + d * 32 + r32]; ss += a[d] * a[d]; }
        ss += __shfl_xor(ss, 1); ss += __shfl_xor(ss, 2); ss += __shfl_xor(ss, 4); ss += __shfl_xor(ss, 8); ss += __shfl_xor(ss, 16);
        const float rs = 1.0f / sqrtf(ss * (1.0f / 128.0f) + EPSN);
#pragma unroll
        for (int d = 0; d < 4; ++d) X[row * 128 + d * 32 + r32] = a[d] * rs * sw[d];
        SBAR();
    }
    asm volatile("s_waitcnt lgkmcnt(0)" ::: "memory");
    const long grow0 = (long)b * SEQ + qb * 256 + wid * 32;
#pragma unroll
    for (int i = 0; i < 8; ++i) {
        const int idx = i * 64 + lane, row = idx >> 4, ch = idx & 15;
        const f32x4 z0 = *(const f32x4*)(X + row * 128 + ch * 8), z1 = *(const f32x4*)(X + row * 128 + ch * 8 + 4);
        const u32x4 g = *(const u32x4*)(T.GA + (grow0 + row) * AW + h * 128 + ch * 8);
        u32x4 w;
        w.x = cvtpk(z0[0] * bf_lo(g.x), z0[1] * bf_hi(g.x)); w.y = cvtpk(z0[2] * bf_lo(g.y), z0[3] * bf_hi(g.y));
        w.z = cvtpk(z1[0] * bf_lo(g.z), z1[1] * bf_hi(g.z)); w.w = cvtpk(z1[2] * bf_lo(g.w), z1[3] * bf_hi(g.w));
        *(u32x4*)(T.MIX + (grow0 + row) * LDP + h * 128 + ch * 8) = w;
    }
    __syncthreads();
}
}

template <int LO> __device__ __forceinline__ void pool_dg(const unsigned (&raw)[47], bf16_t* dst, int p0) {
    constexpr int HI = LO - 1, DGS = 1032;
    float sx = 0.f, sy = 0.f;
#pragma unroll
    for (int j = 8 - LO; j <= 8 + HI; ++j) { sx += bf_lo(raw[j]); sy += bf_hi(raw[j]); }
#pragma unroll
    for (int i = 0; i < 32; ++i) {
        const int p = p0 + i;
        const int cnt = min(p + HI, SEQ - 1) - max(p - LO, 0) + 1;
        const float rc = 1.0f / (float)cnt;
        *(unsigned*)(dst + i * DGS) = cvtpk(sx * rc - bf_lo(raw[i + 8]), sy * rc - bf_hi(raw[i + 8]));
        if (i < 31) { sx += bf_lo(raw[i + 8 + HI + 1]) - bf_lo(raw[i + 8 - LO]); sy += bf_hi(raw[i + 8 + HI + 1]) - bf_hi(raw[i + 8 - LO]); }
    }
}
__device__ __forceinline__ void pool_job(int blk, const bf16_t* U, const bf16_t* GP, const bf16_t* WPT, const float* pscale, bf16_t* MIX, char* lds) {
    int tid = threadIdx.x; asm volatile("" : "+v"(tid));
    const int wid = __builtin_amdgcn_readfirstlane(tid >> 6), lane = tid & 63, r32 = lane & 31, hi = lane >> 5;
    constexpr int DGS = 1032;
    bf16_t* dgs = (bf16_t*)lds;
    const int t0 = blk * 32, b = t0 / SEQ, p0 = t0 % SEQ;
    {
        const int ch = 2 * tid, g = wid >> 1;
        const bf16_t* base = U + (size_t)b * SEQ * AW + ch;
        unsigned raw[47];
#pragma unroll
        for (int j = 0; j < 47; ++j) { const int p = p0 - 8 + j, pc = min(max(p, 0), SEQ - 1); raw[j] = *(const unsigned*)(base + (size_t)pc * AW); }
#pragma unroll
        for (int j = 0; j < 47; ++j) { const int p = p0 - 8 + j; if (p < 0 || p >= SEQ) raw[j] = 0u; }
        if (g == 0) pool_dg<1>(raw, dgs + ch, p0); else if (g == 1) pool_dg<2>(raw, dgs + ch, p0); else if (g == 2) pool_dg<4>(raw, dgs + ch, p0); else pool_dg<8>(raw, dgs + ch, p0);
    }
    __syncthreads();
    {
        const int g = wid >> 1, nbase = (wid & 1) * 128;
        f32x16 acc[4];
#pragma unroll
        for (int nb = 0; nb < 4; ++nb) acc[nb] = f32x16{};
        const bf16_t* wp = WPT + ((size_t)(g * 256 + nbase + r32) * 256 + hi * 8);
        const bf16_t* ap = dgs + r32 * DGS + g * 256 + hi * 8;
#pragma unroll 4
        for (int ks = 0; ks < 16; ++ks) {
            const bf16x8 a = *reinterpret_cast<const bf16x8*>(ap + ks * 16);
#pragma unroll
            for (int nb = 0; nb < 4; ++nb) {
                const bf16x8 bb = *reinterpret_cast<const bf16x8*>(wp + (size_t)nb * 32 * 256 + ks * 16);
                acc[nb] = __builtin_amdgcn_mfma_f32_32x32x16_bf16(a, bb, acc[nb], 0, 0, 0);
            }
        }
        bf16_t* stg = (bf16_t*)(lds + 66048);
#pragma unroll
        for (int nb = 0; nb < 4; ++nb) {
            const int dg = g * 256 + nbase + nb * 32 + r32;
            const float ps = pscale[dg];
#pragma unroll
            for (int r = 0; r < 16; ++r) { const float y = acc[nb][r] * ps; stg[att::crow(r, hi) * 1024 + dg] = (bf16_t)(cvtpk(y, y) & 0xffffu); }
        }
    }
    __syncthreads();
    {
        const bf16_t* stg = (const bf16_t*)(lds + 66048);
#pragma unroll
        for (int i = 0; i < 8; ++i) {
            const int idx = i * 512 + tid, row = idx >> 7, ch = idx & 127;
            const u32x4 y = *(const u32x4*)(stg + row * 1024 + ch * 8);
            const size_t tok = (size_t)t0 + row;
            const u32x4 gq = *(const u32x4*)(GP + tok * AW + ch * 8);
            u32x4 w;
            w.x = cvtpk(bf_lo(y.x) * bf_lo(gq.x), bf_hi(y.x) * bf_hi(gq.x)); w.y = cvtpk(bf_lo(y.y) * bf_lo(gq.y), bf_hi(y.y) * bf_hi(gq.y));
            w.z = cvtpk(bf_lo(y.z) * bf_lo(gq.z), bf_hi(y.z) * bf_hi(gq.z)); w.w = cvtpk(bf_lo(y.w) * bf_lo(gq.w), bf_hi(y.w) * bf_hi(gq.w));
            *(u32x4*)(MIX + tok * LDP + AW + ch * 8) = w;
        }
    }
    __syncthreads();
}

#define XB_TMO      128
#define XB_XCNT(j)  (256  + 64 * (j))
#define XB_XSUB(j)  (1280 + 64 * (j))
#define XB_XGEN(j)  (2304 + 64 * (j))
#define XB_TOP      3328
#define XB_TOPGEN   3392
#define XCD_BAR_WORDS 3456
#define XB_SPIN_CAP (1u << 18)

__device__ __forceinline__ unsigned xb_ld(unsigned* p)              { return __hip_atomic_load(p, __ATOMIC_RELAXED, __HIP_MEMORY_SCOPE_AGENT); }
__device__ __forceinline__ unsigned xb_add(unsigned* p, unsigned v) { return __hip_atomic_fetch_add(p, v, __ATOMIC_RELAXED, __HIP_MEMORY_SCOPE_AGENT); }
__device__ __forceinline__ unsigned xb_xcc_id() { return (unsigned)__builtin_amdgcn_s_getreg((3 << 11) | 20) & 0xFu; }
#define XB_SPIN(cond, bar) do { unsigned _sp = 0; while (cond) { __builtin_amdgcn_s_sleep(1); \
    if ((++_sp & 255u) == 0u) { if (xb_ld(&(bar)[XB_TMO])) break; if (_sp > XB_SPIN_CAP) { atomicAdd(&(bar)[XB_TMO], 1u); break; } } } } while (0)

struct XcdBarrier {
    unsigned* bar; unsigned x;
    volatile LAS unsigned* st;
};

__device__ __forceinline__ XcdBarrier xcd_barrier_post(unsigned* bar, volatile LAS unsigned* st) {
    XcdBarrier b; b.bar = bar; b.x = xb_xcc_id(); b.st = st;
    if (threadIdx.x == 0) (void)xb_add(&bar[XB_XCNT(b.x)], 1u);
    return b;
}
__device__ __forceinline__ void xcd_barrier_complete(unsigned* bar, unsigned x, unsigned& nloc, unsigned& nx) {
    const unsigned G = gridDim.x * gridDim.y * gridDim.z;
    unsigned sum, cnt, mine, sp = 0u;
    for (;;) {
        sum = 0u; cnt = 0u; mine = 0u;
#pragma unroll
        for (unsigned j = 0; j < 16; ++j) { const unsigned c = xb_ld(&bar[XB_XCNT(j)]); sum += c; cnt += (c > 0u) ? 1u : 0u; mine = (j == x) ? c : mine; }
        if (sum == G) break;
        __builtin_amdgcn_s_sleep(1);
        if ((++sp & 255u) == 0u) { if (xb_ld(&bar[XB_TMO])) break; if (sp > XB_SPIN_CAP) { atomicAdd(&bar[XB_TMO], 1u); break; } }
    }
    nloc = mine > 0u ? mine : 1u; nx = cnt > 0u ? cnt : 1u;
}

__device__ __forceinline__ void xcd_barrier(const XcdBarrier& b) {
    asm volatile("s_waitcnt vmcnt(0)" ::: "memory");
    __syncthreads();
    if (threadIdx.x == 0) {
        unsigned* bar = b.bar;
        __builtin_amdgcn_s_waitcnt(0);
        unsigned nloc = b.st[0], nx = b.st[1];
        if (nloc == 0u) { xcd_barrier_complete(bar, b.x, nloc, nx); b.st[0] = nloc; b.st[1] = nx; }
        const unsigned old = xb_add(&bar[XB_XSUB(b.x)], 1u);
        const unsigned gen = old / nloc;
        if (old + 1u == (gen + 1u) * nloc) {
            __builtin_amdgcn_fence(__ATOMIC_RELEASE, "agent");
            asm volatile("s_waitcnt vmcnt(0)" ::: "memory");
            const unsigned og = xb_add(&bar[XB_TOP], 1u);
            const unsigned tg = og / nx;
            if (og + 1u == (tg + 1u) * nx) xb_add(&bar[XB_TOPGEN], 1u);
            else XB_SPIN(xb_ld(&bar[XB_TOPGEN]) == tg, bar);
            __builtin_amdgcn_fence(__ATOMIC_ACQUIRE, "agent");
            xb_add(&bar[XB_XGEN(b.x)], 1u);
            asm volatile("s_waitcnt vmcnt(0)" ::: "memory");
        } else {
            XB_SPIN(xb_ld(&bar[XB_XGEN(b.x)]) == gen, bar);
            __builtin_amdgcn_fence(__ATOMIC_ACQUIRE, "agent");
            asm volatile("s_waitcnt vmcnt(0)" ::: "memory");
        }
    }
    __syncthreads();
}

struct TItem { const float* W; bf16_t* WT; const float* kscale; int K, N, k0, n0, drow, ldw; };
__device__ __forceinline__ void titem_load(const TItem& t, float (&tv)[32], int lane) {
#pragma unroll
    for (int i = 0; i < 32; ++i) tv[i] = __builtin_nontemporal_load(t.W + (size_t)(t.k0 + 2 * i + (lane >> 5)) * t.N + t.n0 + (lane & 31));
}
__device__ __forceinline__ void titem_finish(const TItem& t, float (&tv)[32], LAS float* scr, int lane) {
    if (t.kscale) {
#pragma unroll
        for (int i = 0; i < 32; ++i) tv[i] *= t.kscale[t.k0 + 2 * i + (lane >> 5)];
    }
#pragma unroll
    for (int i = 0; i < 32; ++i) scr[(2 * i + (lane >> 5)) * 33 + (lane & 31)] = tv[i];
    asm volatile("s_waitcnt lgkmcnt(0)" ::: "memory");
    const int c = lane & 7;
#pragma unroll
    for (int j = 0; j < 4; ++j) { const int n = (lane >> 3) + 8 * j; const LAS float* s = scr + (8 * c) * 33 + n;
        u32x4 o; o.x = cvtpk(s[0 * 33], s[1 * 33]); o.y = cvtpk(s[2 * 33], s[3 * 33]); o.z = cvtpk(s[4 * 33], s[5 * 33]); o.w = cvtpk(s[6 * 33], s[7 * 33]);
        *(u32x4*)(t.WT + (size_t)(t.drow + n) * t.ldw + t.k0 + 8 * c) = o; }
    asm volatile("s_waitcnt lgkmcnt(0)" ::: "memory");
}

struct Args {
    const float* in[13]; float* out; unsigned char* ws;
    double turns[8];
    int ph_lo, ph_hi;
};

__global__ void __launch_bounds__(512, 2) mega_fwd(Args args) {
    extern __shared__ __attribute__((aligned(16))) unsigned char lds[];
    const int tid = threadIdx.x, lane = tid & 63, wave = __builtin_amdgcn_readfirstlane(tid >> 6);
    const int G = gridDim.x, bx = blockIdx.x;
    const int vcu = (G % 8 == 0) ? (bx % 8) * (G / 8) + bx / 8 : bx;
    unsigned char* ws = args.ws;
    const float* x = args.in[0]; const float* norm_w = args.in[1]; const float* w_in = args.in[2]; const float* qnw = args.in[3]; const float* knw = args.in[4];
    const float* lq1 = args.in[5]; const float* lk1 = args.in[6]; const float* lq2 = args.in[7]; const float* lk2 = args.in[8];
    const float* subw = args.in[9]; const float* w_pool = args.in[10]; const float* pscale = args.in[11]; const float* w_out = args.in[12];
    float* ROPE = (float*)(ws + WS_ROPE);
    bf16_t* WPT = (bf16_t*)(ws + WS_WPT); bf16_t* WIT = (bf16_t*)(ws + WS_WIT); bf16_t* WOT = (bf16_t*)(ws + WS_WOT); bf16_t* XS = (bf16_t*)(ws + WS_XS);
    bf16_t* QB = (bf16_t*)(ws + WS_Q); bf16_t* KB = (bf16_t*)(ws + WS_K); bf16_t* VB = (bf16_t*)(ws + WS_V);
    bf16_t* GA = (bf16_t*)(ws + WS_GA); bf16_t* UB = (bf16_t*)(ws + WS_U); bf16_t* GP = (bf16_t*)(ws + WS_GP); bf16_t* MIX = (bf16_t*)(ws + WS_MIX);
    const int lo = args.ph_lo, hi = args.ph_hi;
    volatile LAS unsigned* MISC = (volatile LAS unsigned*)((LAS unsigned char*)lds + 133120);
    if (tid < 2) MISC[tid] = 0u;
    __syncthreads();
    XcdBarrier bar = xcd_barrier_post((unsigned*)(ws + WS_CTL), MISC);
#ifdef ONLY_PHASE
#define IN(k) ((k) == ONLY_PHASE && lo <= (k) && (k) < hi)
#else
#define IN(k) (lo <= (k) && (k) < hi)
#endif
#define SEAM(k) do { if (IN(k) && IN((k) + 1)) { if ((k) == 0) cg::this_grid().sync(); else xcd_barrier(bar); } } while (0)

    if (IN(0)) {
        LAS float* scr = (LAS float*)((LAS unsigned char*)lds + wave * 16384);
        const int gw = vcu * 8 + wave, NGW = G * 8;
        constexpr int I_IN = (DM / 64) * (NIN / 32), I_OUT = (DM / 64) * (DM / 32), I_P = 4 * (256 / 64) * (256 / 32);
        auto decode = [&](int it) -> TItem {
            TItem t; int r = it;
            if (r < I_IN) { const int nblk = NIN / 32, kb = r / nblk, nb = r % nblk, n0 = nb * 32, a = n0 & 255;
                t.W = w_in; t.WT = WIT; t.kscale = norm_w; t.K = DM; t.ldw = LDP; t.N = NIN; t.k0 = kb * 64; t.n0 = n0; t.drow = (n0 & ~255) + ((a >> 5) & 1) * 128 + (a >> 6) * 32; return t; }
            r -= I_IN;
            if (r < I_OUT) { const int nblk = DM / 32, kb = r / nblk, nb = r % nblk;
                t.W = w_out; t.WT = WOT; t.kscale = nullptr; t.K = DM; t.ldw = LDP; t.N = DM; t.k0 = kb * 64; t.n0 = nb * 32; t.drow = nb * 32; return t; }
            r -= I_OUT;
            { const int g = r / 32, rr = r % 32, kb = rr / 8, nb = rr % 8;
              t.W = w_pool + (size_t)g * 65536; t.WT = WPT + (size_t)g * 65536; t.kscale = nullptr; t.K = 256; t.ldw = 256; t.N = 256; t.k0 = kb * 64; t.n0 = nb * 32; t.drow = nb * 32; return t; }
        };
        constexpr int NIT = I_IN + I_OUT + I_P;
        for (int it = gw; it < NIT; it += 2 * NGW) {
            const int it1 = it + NGW; const bool two = it1 < NIT;
            const TItem ta = decode(it), tb = decode(two ? it1 : it);
            float va[32], vb[32];
            titem_load(ta, va, lane);
            if (two) titem_load(tb, vb, lane);
            titem_finish(ta, va, scr, lane);
            if (two) titem_finish(tb, vb, scr, lane);
        }
        for (int m = gw; m < MTOK; m += 2 * NGW) {
            const int m2 = (m + NGW < MTOK) ? m + NGW : m;
            const f32x4* xr0 = (const f32x4*)(x + (size_t)m * DM) + lane; const f32x4* xr1 = (const f32x4*)(x + (size_t)m2 * DM) + lane;
            f32x4 v[8], w2[8]; float s0 = 0.f, s1 = 0.f;
#pragma unroll
            for (int j = 0; j < 8; ++j) { v[j] = __builtin_nontemporal_load(xr0 + 64 * j); w2[j] = __builtin_nontemporal_load(xr1 + 64 * j); }
#pragma unroll
            for (int j = 0; j < 8; ++j) { s0 += (v[j].x * v[j].x + v[j].y * v[j].y) + (v[j].z * v[j].z + v[j].w * v[j].w); s1 += (w2[j].x * w2[j].x + w2[j].y * w2[j].y) + (w2[j].z * w2[j].z + w2[j].w * w2[j].w); }
            const float r0 = 1.0f / sqrtf(wave_sum(s0) * (1.0f / DM) + EPSN), r1 = 1.0f / sqrtf(wave_sum(s1) * (1.0f / DM) + EPSN);
            u32x2* o0 = (u32x2*)(XS + (size_t)m * LDP) + lane; u32x2* o1 = (u32x2*)(XS + (size_t)m2 * LDP) + lane;
#pragma unroll
            for (int j = 0; j < 8; ++j) { u32x2 w; w.x = cvtpk(v[j].x * r0, v[j].y * r0); w.y = cvtpk(v[j].z * r0, v[j].w * r0); o0[64 * j] = w;
                                          u32x2 y; y.x = cvtpk(w2[j].x * r1, w2[j].y * r1); y.y = cvtpk(w2[j].z * r1, w2[j].w * r1); o1[64 * j] = y; }
        }
        for (int e = (vcu * 512 + tid); e < SEQ * 8; e += G * 512) {
            const int pos = e >> 3, i = e & 7;
            const double t = (double)pos * args.turns[i];
            const float fr = (float)(t - floor(t));
            ROPE[pos * 16 + i] = __builtin_amdgcn_cosf(fr);
            ROPE[pos * 16 + 8 + i] = __builtin_amdgcn_sinf(fr);
        }
    }
    SEAM(0);

    if (IN(1)) {
        pg8::Gemm g{XS, WIT, MTOK, NIN, DM, LDP}; pg8::StaticOrder S; S.init(MTOK, NIN, G, bx);
        EpiProj E{QB, KB, VB, GA, UB, GP, qnw, knw, ROPE, 0.125f * LOG2E};
        pg8::gemm_phase<EpiProj, pg8::StaticOrder, true, true>((LAS unsigned char*)lds, g, S, E);
    }
    SEAM(1);

    if (IN(2)) {
        const float d1 = wave_sum(lq1[lane] * lk1[lane]), d2 = wave_sum(lq2[lane] * lk2[lane]);
        const float lam = __expf(d1) - __expf(d2) + LAM_INIT;
        const float mq = wave_max(fabsf(qnw[lane])), mk = wave_max(fabsf(knw[lane]));
        const float M2 = 8.0f * mq * mk * LOG2E * 1.02f;
        const float lam_s = __uint_as_float(__builtin_amdgcn_readfirstlane(__float_as_uint(lam)));
        const float nm2_s = __uint_as_float(__builtin_amdgcn_readfirstlane(__float_as_uint(-M2)));
        att::Tensors T{QB, KB, VB, GA, MIX, subw, lam_s, nm2_s};
        for (int u = vcu; u < 256; u += G) { const int bh = u >> 4, qb = u & 15;
            if (nm2_s < -40.0f) att2::unit<true>(bh >> 3, bh & 7, qb, T, (char*)lds); else att2::unit<false>(bh >> 3, bh & 7, qb, T, (char*)lds); }
        for (int blk = vcu; blk < MTOK / 32; blk += G) pool_job(blk, UB, GP, WPT, pscale, MIX, (char*)lds);
    }
    SEAM(2);

    if (IN(3)) {
        pg8::Gemm g{MIX, WOT, MTOK, DM, DM, LDP}; pg8::StaticOrder S; S.init(MTOK, DM, G, bx);
        EpiOut E{x, args.out};
        pg8::gemm_phase<EpiOut, pg8::StaticOrder, true, true>((LAS unsigned char*)lds, g, S, E);
    }
#undef IN
#undef SEAM
}

constexpr int LDS_BYTES = 135168;
extern "C" void kernel_launch(void* const* d_in, const int* in_sizes, int n_in, void* d_out, int out_size, void* d_ws, size_t ws_size, hipStream_t stream) {
    static int grid = 0;
    if (grid == 0) {
        if (n_in != 13 || in_sizes[0] != MTOK * DM || out_size != MTOK * DM || ws_size < WS_END) { fprintf(stderr, "kernel_launch: unexpected shapes\n"); grid = -1; return; }
        int dev = 0, cus = 0, per_cu = 0;
        (void)hipGetDevice(&dev);
        (void)hipDeviceGetAttribute(&cus, hipDeviceAttributeMultiprocessorCount, dev);
        if (hipFuncSetAttribute((const void*)mega_fwd, hipFuncAttributeMaxDynamicSharedMemorySize, LDS_BYTES) != hipSuccess) { fprintf(stderr, "kernel_launch: hipFuncSetAttribute failed\n"); grid = -1; return; }
        if (hipOccupancyMaxActiveBlocksPerMultiprocessor(&per_cu, (const void*)mega_fwd, 512, LDS_BYTES) != hipSuccess || per_cu < 1) { fprintf(stderr, "kernel_launch: occupancy query failed (%d)\n", per_cu); per_cu = 1; }
        (void)hipGetLastError();
        grid = cus * (per_cu > 1 ? 1 : per_cu);
        if (grid > 256) grid = 256;
    }
    if (grid < 0) return;
    Args a{};
    for (int i = 0; i < 13; ++i) a.in[i] = (const float*)d_in[i];
    a.out = (float*)d_out; a.ws = (unsigned char*)d_ws;
    for (int i = 0; i < 8; ++i) a.turns[i] = std::pow(500000.0, -(double)(2 * i) / 16.0) / 6.283185307179586476925;
    constexpr int NL = MK_N_LAUNCHES;
    (void)hipMemsetAsync((char*)d_ws + WS_CTL, 0, CTL_BYTES, stream);
    if (NL == 1) {
        a.ph_lo = 0; a.ph_hi = 4;
        void* kargs[] = {&a};
        hipError_t e = hipLaunchCooperativeKernel((const void*)mega_fwd, dim3(grid), dim3(512), kargs, LDS_BYTES, stream);
        if (e != hipSuccess) fprintf(stderr, "cooperative launch failed: %s (grid %d)\n", hipGetErrorString(e), grid);
        if (PROBE_EXTRA_PHASE >= 0) { a.ph_lo = PROBE_EXTRA_PHASE; a.ph_hi = PROBE_EXTRA_PHASE + 1; hipLaunchKernelGGL(mega_fwd, dim3(grid), dim3(512), LDS_BYTES, stream, a); }
    } else {
        for (int p = 0; p < 4; ++p) { a.ph_lo = p; a.ph_hi = p + 1; hipLaunchKernelGGL(mega_fwd, dim3(grid), dim3(512), LDS_BYTES, stream, a); }
    }
}
```

```cpp
#include <hip/hip_runtime.h>
#include <hip/hip_cooperative_groups.h>
#include <hip/hip_bf16.h>
#include <cstdio>
#include <cstdint>
#include <cmath>
namespace cg = cooperative_groups;

#ifndef PROBE_EXTRA_PHASE
#define PROBE_EXTRA_PHASE -1
#endif
#ifndef MK_N_LAUNCHES
#define MK_N_LAUNCHES 1
#endif

namespace pg8 {
#define PG8_LAS __attribute__((address_space(3)))
typedef unsigned short bf16_t;
typedef short bf16x8 __attribute__((ext_vector_type(8)));
typedef float f32x4 __attribute__((ext_vector_type(4)));
typedef unsigned u32x4 __attribute__((ext_vector_type(4)));
constexpr int BM = 256, BK = 64, HALF = 128, HTB = HALF * BK * 2  , STAGE_BYTES = 8 * HTB, NXCD = 8, WGM = 8;

__host__ __device__ __forceinline__ int lds_byte(int r, int c) { const int st = (r >> 4) * 2 + (c >> 5), rr = r & 15, cc = c & 31, ob = rr * 64 + cc * 2; return st * 1024 + (ob ^ (((ob >> 9) & 1) << 5)); }
__host__ __device__ __forceinline__ void stage_rc(int b, int& R, int& C) { const int st = b / 1024, sb = b % 1024, swz = sb ^ (((sb >> 9) & 1) << 5); R = (st >> 1) * 16 + swz / 64; C = (st & 1) * 32 + (swz % 64) / 2; }
__host__ __device__ __forceinline__ int perm32(int rho) { const int n = rho >> 4, i = rho & 15; return 8 * (i >> 2) + 4 * n + (i & 3); }

struct Unit { int pm, pn; };
struct Gemm { const bf16_t* A; const bf16_t* Bt; int M, N, K, ld; };

struct StaticOrder {
    int nM, nN, nwg, G, c;
    __host__ __device__ void init(int M, int N, int G_, int c_) { nM = M / BM; nN = N / BM; nwg = nM * nN; G = G_; c = c_; }
    __host__ __device__ bool next(int i, Unit& u) const {
        const long L = (long)i * G + c; if (L >= nwg) return false;
        int wgid = (int)L; { const int q = nwg / NXCD, r = nwg % NXCD, xcd = wgid % NXCD, off = wgid / NXCD; wgid = (xcd < r ? xcd * (q + 1) : r * (q + 1) + (xcd - r) * q) + off; }
        const int nig = WGM * nN, gid = wgid / nig, fm = gid * WGM, gsz = (nM - fm) < WGM ? (nM - fm) : WGM;
        u.pm = fm + ((wgid % nig) % gsz); u.pn = (wgid % nig) / gsz; return true;
    }
    __device__ __forceinline__ void a_ready(const Unit&) const {}
    __device__ __forceinline__ void done(const Unit&) const {}
};

__device__ __forceinline__ unsigned cvt_pk_bf16(float lo, float hi) { unsigned r; asm volatile("v_cvt_pk_bf16_f32 %0, %1, %2" : "=v"(r) : "v"(lo), "v"(hi)); return r; }
template <class Epi, class Sched, bool ALIGN_EPI = false, bool SP2 = false>
__device__ __forceinline__ void gemm_phase(PG8_LAS unsigned char* lds, const Gemm g, const Sched& S, const Epi& E) {
    int tid = threadIdx.x; asm volatile("" : "+v"(tid));
    const int wid = __builtin_amdgcn_readfirstlane(tid >> 6), lane = tid & 63, wr = wid >> 2, wc = wid & 3, fr = lane & 15, fq = lane >> 4;
    const int K = g.K, nt = K / BK;
    unsigned voffA[2], voffB[2];
#pragma unroll
    for (int i = 0; i < 2; ++i) { int R, C; stage_rc(tid * 16 + i * 8192, R, C); const int Rb = Epi::PERM ? ((R & ~31) + perm32(R & 31)) : R;
        voffA[i] = (unsigned)(R * g.ld + C) * 2u; voffB[i] = (unsigned)(Rb * g.ld + C) * 2u; }
    const size_t kstep = (size_t)(BK * 2);
    const size_t hstep = (size_t)HALF * g.ld * 2;
    const size_t tstep = 2 * hstep;
    const unsigned ldsw = (unsigned)wid * 1024u;
    const int aoff = lds_byte(wr * 64 + fr, fq * 8), boff = lds_byte(wc * 32 + fr, fq * 8);
#define PG8_SA(b, h) (((b) * 2 + (h)) * HTB)
#define PG8_SB(b, h) ((4 + (b) * 2 + (h)) * HTB)
#define PG8_STAGE(bufoff, gbase, voff) do { _Pragma("unroll") for (int _i = 0; _i < 2; ++_i) \
        __builtin_amdgcn_global_load_lds((const unsigned*)((const char*)(gbase) + (voff)[_i]), (PG8_LAS unsigned*)(lds + (bufoff) + ldsw + _i * 8192), 16, 0, 0); } while (0)
#define PG8_LDA(dst, b, h) do { _Pragma("unroll") for (int m = 0; m < 4; ++m) _Pragma("unroll") for (int k = 0; k < 2; ++k) dst[m][k] = *(const PG8_LAS bf16x8*)(lds + PG8_SA(b, h) + aoff + m * 2048 + k * 1024); } while (0)
#define PG8_LDB(dst, b, h) do { _Pragma("unroll") for (int n = 0; n < 2; ++n) _Pragma("unroll") for (int k = 0; k < 2; ++k) dst[n][k] = *(const PG8_LAS bf16x8*)(lds + PG8_SB(b, h) + boff + n * 2048 + k * 1024); } while (0)
#define PG8_MMA(ai, bj, At, Bt) do { __builtin_amdgcn_s_setprio(1); _Pragma("unroll") for (int m = 0; m < 4; ++m) _Pragma("unroll") for (int n = 0; n < 2; ++n) _Pragma("unroll") for (int k = 0; k < 2; ++k) \
        acc[ai][bj][m][n] = __builtin_amdgcn_mfma_f32_16x16x32_bf16(Bt[n][k], At[m][k], acc[ai][bj][m][n], 0, 0, 0); __builtin_amdgcn_s_setprio(0); } while (0)
#define PG8_WAIT_V(n) asm volatile("s_waitcnt vmcnt(" #n ")" ::: "memory")
#define PG8_WAIT_L(n) asm volatile("s_waitcnt lgkmcnt(" #n ")" ::: "memory")
#define PG8_BAR __builtin_amdgcn_s_barrier()
#define PG8_SCHED __builtin_amdgcn_sched_barrier(0)
    Unit cur, nxt; int ui = 0;
    if (!S.next(0, cur)) return;
    f32x4 acc[2][2][4][2];
    if constexpr (Epi::INIT) E.init(acc, cur, wr, wc, fr, fq);
    else {
#pragma unroll
    for (int a = 0; a < 2; ++a)
#pragma unroll
        for (int b = 0; b < 2; ++b)
#pragma unroll
            for (int m = 0; m < 4; ++m)
#pragma unroll
                for (int n = 0; n < 2; ++n) acc[a][b][m][n] = (f32x4){0.f, 0.f, 0.f, 0.f};
    }
    bf16x8 At[4][2], B0[2][2], B1[2][2];
    const char* cA = (const char*)g.A + (size_t)cur.pm * tstep; const char* cB = (const char*)g.Bt + (size_t)cur.pn * tstep;
    S.a_ready(cur);
    if constexpr (SP2) {
        PG8_STAGE(PG8_SB(0, 0), cB, voffB); PG8_STAGE(PG8_SB(0, 1), cB + hstep, voffB); PG8_STAGE(PG8_SA(0, 0), cA, voffA); PG8_STAGE(PG8_SA(0, 1), cA + hstep, voffA);
        if (wr == 1) PG8_BAR;
        PG8_WAIT_V(2); PG8_BAR;
        PG8_STAGE(PG8_SB(1, 0), cB + kstep, voffB); PG8_STAGE(PG8_SA(1, 0), cA + kstep, voffA); PG8_STAGE(PG8_SB(1, 1), cB + hstep + kstep, voffB);
        PG8_WAIT_V(6); PG8_BAR;
    } else {
        PG8_STAGE(PG8_SB(0, 0), cB, voffB); PG8_STAGE(PG8_SA(0, 0), cA, voffA); PG8_STAGE(PG8_SB(0, 1), cB + hstep, voffB); PG8_STAGE(PG8_SA(0, 1), cA + hstep, voffA);
        if (wr == 1) PG8_BAR;
        PG8_WAIT_V(4); PG8_BAR;
        PG8_STAGE(PG8_SB(1, 0), cB + kstep, voffB); PG8_STAGE(PG8_SA(1, 0), cA + kstep, voffA); PG8_STAGE(PG8_SB(1, 1), cB + hstep + kstep, voffB);
        PG8_WAIT_V(6); PG8_BAR;
    }
    for (;;) {
        const bool has_next = S.next(ui + 1, nxt);
        const char* nA = has_next ? (const char*)g.A + (size_t)nxt.pm * tstep : cA; const char* nB = has_next ? (const char*)g.Bt + (size_t)nxt.pn * tstep : cB;
        for (int t = 0; t < nt; t += 2) {
            const bool last = (t == nt - 2);
            const char* a1 = cA + (size_t)(t + 1) * kstep;
            const char* a2 = last ? nA : cA + (size_t)(t + 2) * kstep; const char* b2 = last ? nB : cB + (size_t)(t + 2) * kstep;
            const char* a3 = a2 + kstep; const char* b3 = b2 + kstep;
            if (last && has_next) S.a_ready(nxt);
            if constexpr (SP2) {
            PG8_LDB(B0, 0, 0); PG8_LDB(B1, 0, 1); PG8_SCHED; PG8_LDA(At, 0, 0); PG8_STAGE(PG8_SA(1, 1), a1 + hstep, voffA);
            PG8_WAIT_V(8); PG8_WAIT_L(0); PG8_BAR; PG8_MMA(0, 0, At, B0); PG8_MMA(0, 1, At, B1); PG8_BAR; PG8_SCHED;
            PG8_LDA(At, 0, 1); PG8_STAGE(PG8_SB(0, 0), b2, voffB); PG8_STAGE(PG8_SB(0, 1), b2 + hstep, voffB); PG8_STAGE(PG8_SA(0, 0), a2, voffA);
            PG8_WAIT_V(8); PG8_WAIT_L(0); PG8_BAR; PG8_MMA(1, 0, At, B0); PG8_MMA(1, 1, At, B1); PG8_BAR; PG8_SCHED;
            PG8_LDB(B0, 1, 0); PG8_LDB(B1, 1, 1); PG8_SCHED; PG8_LDA(At, 1, 0); PG8_STAGE(PG8_SA(0, 1), a2 + hstep, voffA);
            PG8_WAIT_V(8); PG8_WAIT_L(0); PG8_BAR; PG8_MMA(0, 0, At, B0); PG8_MMA(0, 1, At, B1); PG8_BAR; PG8_SCHED;
            PG8_LDA(At, 1, 1); PG8_STAGE(PG8_SB(1, 0), b3, voffB); PG8_STAGE(PG8_SB(1, 1), b3 + hstep, voffB); PG8_STAGE(PG8_SA(1, 0), a3, voffA);
            PG8_WAIT_V(8); PG8_WAIT_L(0); PG8_BAR; PG8_MMA(1, 0, At, B0); PG8_MMA(1, 1, At, B1); PG8_BAR; PG8_SCHED;
            } else {
            PG8_LDB(B0, 0, 0); PG8_SCHED; PG8_LDA(At, 0, 0); PG8_STAGE(PG8_SA(1, 1), a1 + hstep, voffA);
            PG8_WAIT_L(8); PG8_BAR; PG8_WAIT_L(0); PG8_MMA(0, 0, At, B0); PG8_BAR; PG8_SCHED;
            PG8_LDB(B1, 0, 1); PG8_STAGE(PG8_SB(0, 0), b2, voffB);
            PG8_BAR; PG8_WAIT_L(0); PG8_MMA(0, 1, At, B1); PG8_BAR;
            PG8_LDA(At, 0, 1); PG8_STAGE(PG8_SA(0, 0), a2, voffA);
            PG8_BAR; PG8_WAIT_L(0); PG8_MMA(1, 0, At, B0); PG8_BAR; PG8_SCHED;
            PG8_STAGE(PG8_SB(0, 1), b2 + hstep, voffB);
            PG8_WAIT_V(6); PG8_BAR; PG8_MMA(1, 1, At, B1); PG8_BAR;
            PG8_LDB(B0, 1, 0); PG8_SCHED; PG8_LDA(At, 1, 0); PG8_STAGE(PG8_SA(0, 1), a2 + hstep, voffA);
            PG8_WAIT_L(8); PG8_BAR; PG8_WAIT_L(0); PG8_MMA(0, 0, At, B0); PG8_BAR; PG8_SCHED;
            PG8_LDB(B1, 1, 1); PG8_STAGE(PG8_SB(1, 0), b3, voffB);
            PG8_BAR; PG8_WAIT_L(0); PG8_MMA(0, 1, At, B1); PG8_BAR;
            PG8_LDA(At, 1, 1); PG8_STAGE(PG8_SA(1, 0), a3, voffA);
            PG8_BAR; PG8_WAIT_L(0); PG8_MMA(1, 0, At, B0); PG8_BAR; PG8_SCHED;
            PG8_STAGE(PG8_SB(1, 1), b3 + hstep, voffB);
            PG8_WAIT_V(6); PG8_BAR; PG8_MMA(1, 1, At, B1); PG8_BAR;
            }
        }
        if constexpr (ALIGN_EPI) { if (wr == 0) PG8_BAR; }
        if constexpr (!Epi::AFTER_DRAIN) { E(acc, cur, wr, wc, fr, fq); S.done(cur); }
        if (!has_next) break;
        if constexpr (Epi::INIT) E.init(acc, nxt, wr, wc, fr, fq);
        else {
#pragma unroll
        for (int a = 0; a < 2; ++a)
#pragma unroll
            for (int b = 0; b < 2; ++b)
#pragma unroll
                for (int m = 0; m < 4; ++m)
#pragma unroll
                    for (int n = 0; n < 2; ++n) acc[a][b][m][n] = (f32x4){0.f, 0.f, 0.f, 0.f};
        }
        cur = nxt; cA = nA; cB = nB; ++ui;
        if constexpr (ALIGN_EPI) { if (wr == 1) PG8_BAR; }
    }
    PG8_WAIT_V(0);
    if constexpr (!ALIGN_EPI) { if (wr == 0) PG8_BAR; }
    PG8_BAR;
    if constexpr (Epi::AFTER_DRAIN) { E.fused(acc, cur, wr, wc, fr, fq, lds, wid, lane); S.done(cur); }
#undef PG8_SA
#undef PG8_SB
#undef PG8_STAGE
#undef PG8_LDA
#undef PG8_LDB
#undef PG8_MMA
#undef PG8_WAIT_V
#undef PG8_WAIT_L
#undef PG8_BAR
#undef PG8_SCHED
}
}

constexpr int BATCH = 2, SEQ = 4096, DM = 2048, MTOK = BATCH * SEQ;
constexpr int AW = 1024, PW = 1024, NIN = 6144, HD = 64, NH = 8;
constexpr float EPSN = 1e-6f;
constexpr float LAM_INIT = 0.2f;
constexpr float LOG2E = 1.4426950408889634f;

constexpr size_t MiB = 1u << 20;
constexpr size_t WS_ROPE = 0;
constexpr size_t WS_CTL = 512 * 1024, CTL_BYTES = 16384;
constexpr size_t WS_WPT = 1 * MiB;
constexpr int LDP = DM + 64;
constexpr size_t WS_WIT = 2 * MiB;
constexpr size_t WS_WOT = 27 * MiB;
constexpr size_t WS_XS = 36 * MiB;
constexpr size_t WS_Q = 70 * MiB, WS_K = 86 * MiB, WS_V = 102 * MiB, WS_GA = 118 * MiB, WS_U = 134 * MiB, WS_GP = 150 * MiB;
constexpr size_t WS_MIX = 166 * MiB;
constexpr size_t WS_END = 200 * MiB;
static_assert(WS_WIT + (size_t)6144 * LDP * 2 <= WS_WOT && WS_WOT + (size_t)2048 * LDP * 2 <= WS_XS && WS_XS + (size_t)8192 * LDP * 2 <= WS_Q && WS_MIX + (size_t)8192 * LDP * 2 <= WS_END, "d_ws map");

#define LAS __attribute__((address_space(3)))
typedef unsigned short bf16_t;
typedef float f32x4 __attribute__((ext_vector_type(4)));
typedef float f32x2 __attribute__((ext_vector_type(2)));
typedef unsigned u32x4 __attribute__((ext_vector_type(4)));
typedef unsigned u32x2 __attribute__((ext_vector_type(2)));
typedef short bf16x8 __attribute__((ext_vector_type(8)));
typedef short s16x4 __attribute__((ext_vector_type(4)));
typedef float f32x16 __attribute__((ext_vector_type(16)));

typedef __bf16 bf16x2_cv __attribute__((ext_vector_type(2)));
__device__ __forceinline__ unsigned cvtpk(float lo, float hi) { f32x2 v = {lo, hi}; bf16x2_cv b = __builtin_convertvector(v, bf16x2_cv); return __builtin_bit_cast(unsigned, b); }
__device__ __forceinline__ float bf_lo(unsigned w) { return __uint_as_float(w << 16); }
__device__ __forceinline__ float bf_hi(unsigned w) { return __uint_as_float(w & 0xffff0000u); }
__device__ __forceinline__ float silu_f(float x) { return x * __builtin_amdgcn_rcpf(1.0f + __builtin_amdgcn_exp2f(-x * LOG2E)); }
__device__ __forceinline__ float wave_sum(float v) {
#pragma unroll
    for (int o = 1; o < 64; o <<= 1) v += __shfl_xor(v, o);
    return v;
}
__device__ __forceinline__ float wave_max(float v) {
#pragma unroll
    for (int o = 1; o < 64; o <<= 1) v = fmaxf(v, __shfl_xor(v, o));
    return v;
}

struct EpiProj {
    static constexpr bool PERM = true, AFTER_DRAIN = false, INIT = false;
    bf16_t *Q, *K, *V, *GA, *U, *GP; const float *qw, *kw; const float* rope; float qscale;
    __device__ __forceinline__ void operator()(const f32x4 (&acc)[2][2][4][2], const pg8::Unit& u, int wr, int wc, int fr, int fq) const {
        const int type = u.pn >> 2;
        const int col0 = (u.pn & 3) * 256 + wc * 64 + fq * 8;
        const int row0 = u.pm * 256 + wr * 64 + fr;
        if (type <= 1) {
            const float* wsrc = (type == 0 ? qw : kw) + fq * 8;
            const f32x4 w00 = *(const f32x4*)(wsrc), w01 = *(const f32x4*)(wsrc + 4), w10 = *(const f32x4*)(wsrc + 32), w11 = *(const f32x4*)(wsrc + 36);
            bf16_t* dsth = (type == 0 ? Q : K) + (size_t)(((u.pm * 256) >> 12) * NH + (col0 >> 7)) * SEQ * 128 + (col0 & 127);
            const float sc = (type == 0) ? qscale : 1.0f;
            const float sgn = (fq == 0) ? -1.0f : 1.0f;
#pragma unroll
            for (int ai = 0; ai < 2; ++ai) {
                f32x4 rc[4][4];
#pragma unroll
                for (int m = 0; m < 4; ++m) { const float* rp = rope + ((row0 + ai * 128 + m * 16) & (SEQ - 1)) * 16;
#pragma unroll
                    for (int q = 0; q < 4; ++q) rc[m][q] = (fq < 2) ? *(const f32x4*)(rp + 4 * q) : (f32x4){0.f, 0.f, 0.f, 0.f}; }
                asm volatile("" ::: "memory");
#pragma unroll
                for (int m = 0; m < 4; ++m) {
                    const int row = row0 + ai * 128 + m * 16, pos = row & (SEQ - 1);
                    f32x4 v00 = acc[ai][0][m][0], v01 = acc[ai][0][m][1], v10 = acc[ai][1][m][0], v11 = acc[ai][1][m][1];
                    float ss = (v00[0] * v00[0] + v00[1] * v00[1]) + (v00[2] * v00[2] + v00[3] * v00[3]);
                    ss += (v01[0] * v01[0] + v01[1] * v01[1]) + (v01[2] * v01[2] + v01[3] * v01[3]);
                    ss += (v10[0] * v10[0] + v10[1] * v10[1]) + (v10[2] * v10[2] + v10[3] * v10[3]);
                    ss += (v11[0] * v11[0] + v11[1] * v11[1]) + (v11[2] * v11[2] + v11[3] * v11[3]);
                    ss += __shfl_xor(ss, 16); ss += __shfl_xor(ss, 32);
                    const float rs = 1.0f / sqrtf(ss * (1.0f / 64.0f) + EPSN);
                    v00 = v00 * rs * w00; v01 = v01 * rs * w01; v10 = v10 * rs * w10; v11 = v11 * rs * w11;
                    f32x4 o00, o01;
#pragma unroll
                    for (int i = 0; i < 4; ++i) { o00[i] = __shfl_xor(v00[i], 16); o01[i] = __shfl_xor(v01[i], 16); }
                    if (fq < 2) {
                        const f32x4 c0 = rc[m][0], c1 = rc[m][1], s0 = rc[m][2], s1 = rc[m][3];
                        v00 = v00 * c0 + (o00 * s0) * sgn; v01 = v01 * c1 + (o01 * s1) * sgn;
                    }
                    v00 = v00 * sc; v01 = v01 * sc; v10 = v10 * sc; v11 = v11 * sc;
                    u32x4 a, b;
                    a.x = cvtpk(v00[0], v00[1]); a.y = cvtpk(v00[2], v00[3]); a.z = cvtpk(v01[0], v01[1]); a.w = cvtpk(v01[2], v01[3]);
                    b.x = cvtpk(v10[0], v10[1]); b.y = cvtpk(v10[2], v10[3]); b.z = cvtpk(v11[0], v11[1]); b.w = cvtpk(v11[2], v11[3]);
                    bf16_t* rowp = dsth + (size_t)pos * 128;
                    *(u32x4*)(rowp) = a; *(u32x4*)(rowp + 32) = b;
                }
                asm volatile("" ::: "memory");
            }
        } else {
            bf16_t* dst = (type == 2) ? V : (type == 3) ? GA : (type == 4) ? U : GP;
            const bool act = (type == 3) || (type == 5);
            const bool hm = (type == 2);
            const int rstride = hm ? 128 : AW, rmask = hm ? (SEQ - 1) : 0x7fffffff;
            dst += hm ? (size_t)(((u.pm * 256) >> 12) * NH + (col0 >> 7)) * SEQ * 128 + (col0 & 127) : (size_t)col0;
#pragma unroll
            for (int ai = 0; ai < 2; ++ai)
#pragma unroll
                for (int m = 0; m < 4; ++m) {
                    const int row = row0 + ai * 128 + m * 16;
                    bf16_t* rowp = dst + (size_t)(row & rmask) * rstride;
#pragma unroll
                    for (int bj = 0; bj < 2; ++bj) {
                        f32x4 v0 = acc[ai][bj][m][0], v1 = acc[ai][bj][m][1];
                        if (act) {
#pragma unroll
                            for (int i = 0; i < 4; ++i) { v0[i] = silu_f(v0[i]); v1[i] = silu_f(v1[i]); }
                        }
                        u32x4 a; a.x = cvtpk(v0[0], v0[1]); a.y = cvtpk(v0[2], v0[3]); a.z = cvtpk(v1[0], v1[1]); a.w = cvtpk(v1[2], v1[3]);
                        *(u32x4*)(rowp + bj * 32) = a;
                    }
                }
        }
    }
};
struct EpiOut {
    static constexpr bool PERM = true, AFTER_DRAIN = false, INIT = true;
    const float* x; float* out;
    __device__ __forceinline__ void init(f32x4 (&acc)[2][2][4][2], const pg8::Unit& u, int wr, int wc, int fr, int fq) const {
        const int row0 = u.pm * 256 + wr * 64 + fr, col0 = u.pn * 256 + wc * 32 + fq * 8;
#pragma unroll
        for (int ai = 0; ai < 2; ++ai)
#pragma unroll
            for (int m = 0; m < 4; ++m) { const size_t off = (size_t)(row0 + ai * 128 + m * 16) * DM + col0;
#pragma unroll
                for (int bj = 0; bj < 2; ++bj) { acc[ai][bj][m][0] = __builtin_nontemporal_load((const f32x4*)(x + off + bj * 128)); acc[ai][bj][m][1] = __builtin_nontemporal_load((const f32x4*)(x + off + bj * 128 + 4)); } }
    }
    __device__ __forceinline__ void operator()(const f32x4 (&acc)[2][2][4][2], const pg8::Unit& u, int wr, int wc, int fr, int fq) const {
        const int row0 = u.pm * 256 + wr * 64 + fr, col0 = u.pn * 256 + wc * 32 + fq * 8;
#pragma unroll
        for (int ai = 0; ai < 2; ++ai)
#pragma unroll
            for (int m = 0; m < 4; ++m) { const size_t off = (size_t)(row0 + ai * 128 + m * 16) * DM + col0;
#pragma unroll
                for (int bj = 0; bj < 2; ++bj) { *(f32x4*)(out + off + bj * 128) = acc[ai][bj][m][0]; *(f32x4*)(out + off + bj * 128 + 4) = acc[ai][bj][m][1]; } }
    }
};

namespace att {
constexpr int KVBLK = 64, NT = SEQ / KVBLK, LD = 128;
constexpr int SHM_V = KVBLK * 128 * 2, SHM_K = KVBLK * 128 * 2;
constexpr int OFF_V = 0, OFF_K = 2 * SHM_V, OFF_WS = 2 * SHM_V + 2 * SHM_K;
#define KSWZ(row, colB) ((row) * 256 + ((colB) ^ (((row) & 7) << 4)))
#define SBAR() __builtin_amdgcn_sched_barrier(0)
__device__ __forceinline__ int crow(int r, int hi) { return (r & 3) + 8 * (r >> 2) + 4 * hi; }
__device__ __forceinline__ int v_st(int k, int c) { const int kk = (k & ~0xC) | ((k & 4) << 1) | ((k & 8) >> 1); return ((kk >> 3) * 4 + (c >> 5)) * 512 + ((kk & 7) * 32 + (c & 31)) * 2; }
__device__ __forceinline__ int v_rd_base(int lane) { return ((lane & 3) << 3) | (((lane >> 2) & 3) << 6) | (((lane >> 4) & 1) << 5) | (((lane >> 5) & 1) << 8); }
constexpr int v_rd_off(int d0, int ks, int half) { return d0 * 512 + ks * 4096 + half * 2048; }
template <int OFF> __device__ __forceinline__ s16x4 tr_read(int vb) {
    s16x4 r; asm volatile("ds_read_b64_tr_b16 %0, %1 offset:%2" : "=&v"(r) : "v"(vb), "i"(OFF) : "memory"); return r;
}
template <int D0> __device__ __forceinline__ void pv_one(f32x16& od, int vb, bf16x8 pa0, bf16x8 pa1, bf16x8 pa2, bf16x8 pa3) {
    const s16x4 l0 = tr_read<v_rd_off(D0, 0, 0)>(vb), h0 = tr_read<v_rd_off(D0, 0, 1)>(vb), l1 = tr_read<v_rd_off(D0, 1, 0)>(vb), h1 = tr_read<v_rd_off(D0, 1, 1)>(vb);
    const s16x4 l2 = tr_read<v_rd_off(D0, 2, 0)>(vb), h2 = tr_read<v_rd_off(D0, 2, 1)>(vb), l3 = tr_read<v_rd_off(D0, 3, 0)>(vb), h3 = tr_read<v_rd_off(D0, 3, 1)>(vb);
    asm volatile("s_waitcnt lgkmcnt(0)" ::: "memory"); SBAR();
#define PK(L, H) (bf16x8){L[0], L[1], L[2], L[3], H[0], H[1], H[2], H[3]}
    od = __builtin_amdgcn_mfma_f32_32x32x16_bf16(pa0, PK(l0, h0), od, 0, 0, 0);
    od = __builtin_amdgcn_mfma_f32_32x32x16_bf16(pa1, PK(l1, h1), od, 0, 0, 0);
    od = __builtin_amdgcn_mfma_f32_32x32x16_bf16(pa2, PK(l2, h2), od, 0, 0, 0);
    od = __builtin_amdgcn_mfma_f32_32x32x16_bf16(pa3, PK(l3, h3), od, 0, 0, 0);
#undef PK
}
__device__ __forceinline__ void pv_d0(f32x16* o, int vb, bf16x8 pa0, bf16x8 pa1, bf16x8 pa2, bf16x8 pa3) {
    pv_one<0>(o[0], vb, pa0, pa1, pa2, pa3); pv_one<1>(o[1], vb, pa0, pa1, pa2, pa3); pv_one<2>(o[2], vb, pa0, pa1, pa2, pa3); pv_one<3>(o[3], vb, pa0, pa1, pa2, pa3);
}
__device__ __forceinline__ void qkt(f32x16& p0, f32x16& p1, const char* Ks, const bf16x8* qr, int comp, int r32, int hi) {
    const f32x16 zero = f32x16{};
#pragma unroll
    for (int d = 0; d < 4; ++d) { const int cb = ((comp * 4 + d) * 16 + hi * 8) * 2;
        const bf16x8 b0 = *reinterpret_cast<const bf16x8*>(Ks + KSWZ(r32, cb));
        const bf16x8 b1 = *reinterpret_cast<const bf16x8*>(Ks + KSWZ(32 + r32, cb));
        if (d == 0) { p0 = __builtin_amdgcn_mfma_f32_32x32x16_bf16(b0, qr[0], zero, 0, 0, 0); p1 = __builtin_amdgcn_mfma_f32_32x32x16_bf16(b1, qr[0], zero, 0, 0, 0); }
        else { p0 = __builtin_amdgcn_mfma_f32_32x32x16_bf16(b0, qr[d], p0, 0, 0, 0); p1 = __builtin_amdgcn_mfma_f32_32x32x16_bf16(b1, qr[d], p1, 0, 0, 0); } }
}
template <bool SHIFT> __device__ __forceinline__ void partialSM(f32x16& p0, float negM2) {
#pragma unroll
    for (int r = 0; r < 16; ++r) p0[r] = __builtin_amdgcn_exp2f(SHIFT ? p0[r] + negM2 : p0[r]);
}
template <bool SHIFT> __device__ __forceinline__ void finishSM(f32x16& p0, f32x16& p1, float negM2, float& l_reg, bf16x8& pa0, bf16x8& pa1, bf16x8& pa2, bf16x8& pa3) {
#pragma unroll
    for (int r = 0; r < 16; ++r) p1[r] = __builtin_amdgcn_exp2f(SHIFT ? p1[r] + negM2 : p1[r]);
    float ps = 0.f;
#pragma unroll
    for (int r = 0; r < 16; ++r) ps += p0[r];
#pragma unroll
    for (int r = 0; r < 16; ++r) ps += p1[r];
    l_reg += ps;
#define PK4(P, BASE, OUT) do { unsigned a0 = cvtpk(P[BASE + 0], P[BASE + 1]), a1 = cvtpk(P[BASE + 2], P[BASE + 3]);   \
    unsigned b0 = cvtpk(P[BASE + 4], P[BASE + 5]), b1 = cvtpk(P[BASE + 6], P[BASE + 7]);                              \
    auto r0 = __builtin_amdgcn_permlane32_swap(a0, b0, false, false); auto r1 = __builtin_amdgcn_permlane32_swap(a1, b1, false, false); \
    u32x4 w = {r0[0], r1[0], r0[1], r1[1]}; OUT = *reinterpret_cast<bf16x8*>(&w); } while (0)
    PK4(p0, 0, pa0); PK4(p0, 8, pa1); PK4(p1, 0, pa2); PK4(p1, 8, pa3);
#undef PK4
}

struct Tensors { const bf16_t *Q, *K, *V, *GA; bf16_t* MIX; const float* subw; float lam, negM2; };
__device__ __forceinline__ void epilogue(f32x16 (&o)[4], float l_reg, int b, int h, int qb, const Tensors& T, char* lds);

template <bool SHIFT> __device__ __forceinline__ void unit(int b, int h, int qb, const Tensors& T, char* lds) {
    const float negM2 = T.negM2;
    int tid = threadIdx.x; asm volatile("" : "+v"(tid));
    const int wid = __builtin_amdgcn_readfirstlane(tid >> 6), lane = tid & 63, r32 = lane & 31, hi = lane >> 5;
    const int comp = wid >> 2, rw = wid & 3;
    char* V_lds = lds + OFF_V; char* K_lds = lds + OFF_K;
    float* wsf = (float*)(lds + OFF_WS) + wid * 64;
    const long rowbase = (long)b * SEQ; const int q0 = qb * 128;
    const long hb = (long)(b * NH + h) * SEQ;
    const bf16_t* Kh = T.K + hb * LD; const bf16_t* Vh = T.V + hb * LD;
    bf16x8 qr[4];
    { const bf16_t* Qw = T.Q + (hb + q0 + rw * 32 + r32) * LD + comp * 64 + hi * 8;
#pragma unroll
      for (int d = 0; d < 4; ++d) qr[d] = *reinterpret_cast<const bf16x8*>(Qw + d * 16); }
    float l_reg = 0.f; f32x16 o[4];
#pragma unroll
    for (int d = 0; d < 4; ++d) o[d] = f32x16{};
    const int sr = tid >> 4, sc = (tid & 15) * 8, vst0 = v_st(sr, sc), vst1 = v_st(32 + sr, sc);
    const int vb0 = (int)(uintptr_t)V_lds + v_rd_base(lane);
    struct { bf16x8 vs0, vs1, ks0, ks1; } sr_[2];
#define LD8(p) (*reinterpret_cast<const bf16x8*>(p))
#define SLOAD(i, k0) do { sr_[i].vs0 = LD8(&Vh[(long)((k0) + sr) * LD + sc]); sr_[i].vs1 = LD8(&Vh[(long)((k0) + 32 + sr) * LD + sc]); \
    sr_[i].ks0 = LD8(&Kh[(long)((k0) + sr) * LD + sc]); sr_[i].ks1 = LD8(&Kh[(long)((k0) + 32 + sr) * LD + sc]); } while (0)
#define SWRITE(bb, i) do { *(bf16x8*)(V_lds + (bb) * SHM_V + vst0) = sr_[i].vs0;          \
    *(bf16x8*)(V_lds + (bb) * SHM_V + vst1) = sr_[i].vs1; const int kc = sc * 2;               \
    *(bf16x8*)(K_lds + (bb) * SHM_K + KSWZ(sr, kc)) = sr_[i].ks0;                       \
    *(bf16x8*)(K_lds + (bb) * SHM_K + KSWZ(32 + sr, kc)) = sr_[i].ks1; } while (0)
#define SWAIT() asm volatile("s_waitcnt vmcnt(4)" ::: "memory")
    f32x16 pA0, pA1, pB0, pB1; bf16x8 pa0, pa1, pa2, pa3;
    constexpr int SE = 0, SO = 1;
    SLOAD(SE, 0); asm volatile("s_waitcnt vmcnt(0)" ::: "memory"); SWRITE(0, SE); __syncthreads();
    qkt(pA0, pA1, K_lds, qr, comp, r32, hi); partialSM<SHIFT>(pA0, negM2);
    SLOAD(SO, KVBLK); SLOAD(SE, 2 * KVBLK);
    SWAIT(); SWRITE(1, SO); __syncthreads();
#pragma unroll 1
    for (int j = 1; j + 1 < NT; j += 2) {
        SBAR(); qkt(pB0, pB1, K_lds + SHM_K, qr, comp, r32, hi);
        finishSM<SHIFT>(pA0, pA1, negM2, l_reg, pa0, pa1, pa2, pa3); SBAR();
        SLOAD(SO, (j + 2) * KVBLK); SBAR();
        pv_d0(o, vb0, pa0, pa1, pa2, pa3); partialSM<SHIFT>(pB0, negM2);
        __syncthreads(); SWAIT(); SWRITE(0, SE);
        __syncthreads();
        SBAR(); qkt(pA0, pA1, K_lds, qr, comp, r32, hi);
        finishSM<SHIFT>(pB0, pB1, negM2, l_reg, pa0, pa1, pa2, pa3); SBAR();
        SLOAD(SE, (j + 3 < NT ? j + 3 : NT - 1) * KVBLK); SBAR();
        pv_d0(o, vb0 + SHM_V, pa0, pa1, pa2, pa3); partialSM<SHIFT>(pA0, negM2);
        __syncthreads(); SWAIT(); SWRITE(1, SO);
        __syncthreads();
    }
    SBAR(); qkt(pB0, pB1, K_lds + SHM_K, qr, comp, r32, hi);
    finishSM<SHIFT>(pA0, pA1, negM2, l_reg, pa0, pa1, pa2, pa3); SBAR();
    pv_d0(o, vb0, pa0, pa1, pa2, pa3); partialSM<SHIFT>(pB0, negM2);
    finishSM<SHIFT>(pB0, pB1, negM2, l_reg, pa0, pa1, pa2, pa3); SBAR();
    pv_d0(o, vb0 + SHM_V, pa0, pa1, pa2, pa3);
#undef SLOAD
#undef SWRITE
#undef SWAIT
#undef LD8
    epilogue(o, l_reg, b, h, qb, T, lds);
}
__device__ __forceinline__ void epilogue(f32x16 (&o)[4], float l_reg, int b, int h, int qb, const Tensors& T, char* lds) {
    int tid = threadIdx.x; asm volatile("" : "+v"(tid));
    const int wid = __builtin_amdgcn_readfirstlane(tid >> 6), lane = tid & 63, r32 = lane & 31, hi = lane >> 5;
    const int comp = wid >> 2, rw = wid & 3;
    float* wsf = (float*)(lds + OFF_WS) + wid * 64;
    const long rowbase = (long)b * SEQ; const int q0 = qb * 128;
    { auto rr = __builtin_amdgcn_permlane32_swap(__float_as_uint(l_reg), __float_as_uint(l_reg), false, false); l_reg = __uint_as_float(rr[0]) + __uint_as_float(rr[1]); }
    if (hi == 0) wsf[r32] = l_reg;
    asm volatile("s_waitcnt lgkmcnt(0)" ::: "memory");
    float rli[16];
#pragma unroll
    for (int r = 0; r < 16; ++r) rli[r] = __builtin_amdgcn_rcpf(wsf[crow(r, hi)]);
    __syncthreads();
    float* X = (float*)lds + rw * 4096;
    if (comp == 1) {
        const float lam = T.lam;
#pragma unroll
        for (int r = 0; r < 16; ++r) { const float f = rli[r] * lam;
#pragma unroll
            for (int d = 0; d < 4; ++d) X[crow(r, hi) * 128 + d * 32 + r32] = o[d][r] * f; }
    }
    __syncthreads();
    if (comp == 0) {
        float sw[4];
#pragma unroll
        for (int d = 0; d < 4; ++d) sw[d] = T.subw[d * 32 + r32] * (1.0f - LAM_INIT);
#pragma unroll
        for (int r = 0; r < 16; ++r) {
            float a[4]; float ss = 0.f;
#pragma unroll
            for (int d = 0; d < 4; ++d) { a[d] = o[d][r] * rli[r] - X[crow(r, hi) * 128 + d * 32 + r32]; ss += a[d] * a[d]; }
            ss += __shfl_xor(ss, 1); ss += __shfl_xor(ss, 2); ss += __shfl_xor(ss, 4); ss += __shfl_xor(ss, 8); ss += __shfl_xor(ss, 16);
            const float rs = 1.0f / sqrtf(ss * (1.0f / 128.0f) + EPSN);
#pragma unroll
            for (int d = 0; d < 4; ++d) X[crow(r, hi) * 128 + d * 32 + r32] = a[d] * rs * sw[d];
        }
    }
    __syncthreads();
#pragma unroll
    for (int i = 0; i < 4; ++i) {
        const int idx = i * 64 + lane, row = comp * 16 + (idx >> 4), ch = idx & 15;
        const f32x4 z0 = *(const f32x4*)(X + row * 128 + ch * 8), z1 = *(const f32x4*)(X + row * 128 + ch * 8 + 4);
        const long grow = rowbase + q0 + rw * 32 + row;
        const u32x4 g = *(const u32x4*)(T.GA + grow * AW + h * 128 + ch * 8);
        u32x4 w;
        w.x = cvtpk(z0[0] * bf_lo(g.x), z0[1] * bf_hi(g.x)); w.y = cvtpk(z0[2] * bf_lo(g.y), z0[3] * bf_hi(g.y));
        w.z = cvtpk(z1[0] * bf_lo(g.z), z1[1] * bf_hi(g.z)); w.w = cvtpk(z1[2] * bf_lo(g.w), z1[3] * bf_hi(g.w));
        *(u32x4*)(T.MIX + grow * DM + h * 128 + ch * 8) = w;
    }
    __syncthreads();
}
}


namespace att2 {
#ifndef DEBUG_SYNC_COPY
#define DEBUG_SYNC_COPY 0
#endif
using att::crow; using att::Tensors; using att::tr_read; using att::v_rd_off; using att::v_rd_base;
constexpr int NT = SEQ / 64, SHM = 16384;
constexpr int OFF_Q = 0, OFF_V = 65536, OFF_K = 98304, OFF_WS = 131072;
typedef LAS unsigned char* ldsp;
__device__ __forceinline__ void glds16s(unsigned voff, const void* sbase, unsigned lds_dst) { unsigned keep;
    asm volatile("s_mov_b32 %0, m0\n\ts_mov_b32 m0, %3\n\ts_nop 0\n\tglobal_load_lds_dwordx4 %1, %2\n\ts_mov_b32 m0, %0" : "=&s"(keep) : "v"(voff), "s"(sbase), "s"(lds_dst) : "memory"); }
typedef __bf16 bf16x2_t __attribute__((ext_vector_type(2)));
__device__ __forceinline__ unsigned cvtpk_s(float lo, float hi) { f32x2 v = {lo, hi}; bf16x2_t b = __builtin_convertvector(v, bf16x2_t); return __builtin_bit_cast(unsigned, b); }
template <int H, int D0> __device__ __forceinline__ void v_rd4(s16x4 (&f)[4], int vb) {
    f[0] = tr_read<v_rd_off(D0, 2 * H, 0)>(vb); f[1] = tr_read<v_rd_off(D0, 2 * H, 1)>(vb); f[2] = tr_read<v_rd_off(D0, 2 * H + 1, 0)>(vb); f[3] = tr_read<v_rd_off(D0, 2 * H + 1, 1)>(vb);
}
__device__ __forceinline__ void pv_mma(f32x16& oa, f32x16& ob, const s16x4 (&f)[4], const bf16x8 (&pa)[2], const bf16x8 (&pb)[2]) {
#define PK(L, H_) (bf16x8){L[0], L[1], L[2], L[3], H_[0], H_[1], H_[2], H_[3]}
    const bf16x8 v0 = PK(f[0], f[1]), v1 = PK(f[2], f[3]);
#undef PK
    oa = __builtin_amdgcn_mfma_f32_32x32x16_bf16(pa[0], v0, oa, 0, 0, 0);
    ob = __builtin_amdgcn_mfma_f32_32x32x16_bf16(pb[0], v0, ob, 0, 0, 0);
    oa = __builtin_amdgcn_mfma_f32_32x32x16_bf16(pa[1], v1, oa, 0, 0, 0);
    ob = __builtin_amdgcn_mfma_f32_32x32x16_bf16(pb[1], v1, ob, 0, 0, 0);
}
template <int H> __device__ __forceinline__ void pv_half(f32x16 (&o0)[4], f32x16 (&o1)[4], int vb, const bf16x8 (&pa)[2], const bf16x8 (&pb)[2]) {
    s16x4 fa[4], fb[4];
    SBAR();
    v_rd4<H, 0>(fa, vb); v_rd4<H, 1>(fb, vb);
    asm volatile("s_waitcnt lgkmcnt(4)" ::: "memory"); SBAR();
    pv_mma(o0[0], o1[0], fa, pa, pb); SBAR();
    v_rd4<H, 2>(fa, vb);
    asm volatile("s_waitcnt lgkmcnt(4)" ::: "memory"); SBAR();
    pv_mma(o0[1], o1[1], fb, pa, pb); SBAR();
    v_rd4<H, 3>(fb, vb);
    asm volatile("s_waitcnt lgkmcnt(4)" ::: "memory"); SBAR();
    pv_mma(o0[2], o1[2], fa, pa, pb); SBAR();
    asm volatile("s_waitcnt lgkmcnt(0)" ::: "memory"); SBAR();
    pv_mma(o0[3], o1[3], fb, pa, pb); SBAR();
}
template <int C, int H> __device__ __forceinline__ void qkt_half(f32x16& p, ldsp Kb, ldsp Qw, const int (&fa)[4]) {
    const f32x16 zero = f32x16{};
#pragma unroll
    for (int d = 0; d < 4; ++d) {
        const bf16x8 q = *(const LAS bf16x8*)(Qw + fa[d] + C * 128);
        const bf16x8 kf = *(const LAS bf16x8*)(Kb + fa[d] + C * 128 + H * 8192);
        if (d == 0) p = __builtin_amdgcn_mfma_f32_32x32x16_bf16(kf, q, zero, 0, 0, 0);
        else p = __builtin_amdgcn_mfma_f32_32x32x16_bf16(kf, q, p, 0, 0, 0); }
}
template <int C, int H> __device__ __forceinline__ void qkt_half_r(f32x16& p, ldsp Kb, const bf16x8 (&qa)[4], const int (&fa)[4]) {
    const f32x16 zero = f32x16{};
#pragma unroll
    for (int d = 0; d < 4; ++d) {
        const bf16x8 kf = *(const LAS bf16x8*)(Kb + fa[d] + C * 128 + H * 8192);
        if (d == 0) p = __builtin_amdgcn_mfma_f32_32x32x16_bf16(kf, qa[0], zero, 0, 0, 0);
        else p = __builtin_amdgcn_mfma_f32_32x32x16_bf16(kf, qa[d], p, 0, 0, 0); }
}
template <bool SHIFT> __device__ __forceinline__ void softmax_half(f32x16& p, float negM2, float& l_reg, bf16x8 (&pa)[2]) {
#pragma unroll
    for (int r = 0; r < 16; ++r) p[r] = __builtin_amdgcn_exp2f(SHIFT ? p[r] + negM2 : p[r]);
#pragma unroll
    for (int r = 0; r < 16; ++r) l_reg += p[r];
#define PK4(P, BASE, OUT) do { unsigned a0 = cvtpk_s(P[BASE + 0], P[BASE + 1]), a1 = cvtpk_s(P[BASE + 2], P[BASE + 3]);   \
    unsigned b0 = cvtpk_s(P[BASE + 4], P[BASE + 5]), b1 = cvtpk_s(P[BASE + 6], P[BASE + 7]);                              \
    auto r0 = __builtin_amdgcn_permlane32_swap(a0, b0, false, false); auto r1 = __builtin_amdgcn_permlane32_swap(a1, b1, false, false); \
    u32x4 w = {r0[0], r1[0], r0[1], r1[1]}; OUT = *reinterpret_cast<bf16x8*>(&w); } while (0)
    PK4(p, 0, pa[0]); PK4(p, 8, pa[1]);
#undef PK4
}
template <bool SHIFT, int H, class Mid> __device__ __forceinline__ void half_tile(ldsp Kb, int vb, ldsp Qw, const int (&fa)[4], const bf16x8 (&qa)[4], const bf16x8 (&qb_)[4], float negM2, f32x16 (&o0)[4], f32x16 (&o1)[4], float& l0, float& l1, Mid&& mid) {
    f32x16 sa, sb; bf16x8 pa[2], pb[2];
    asm volatile("" : "+v"(l0) : "v"(l1));
    qkt_half_r<0, H>(sa, Kb, qa, fa);
    qkt_half_r<1, H>(sb, Kb, qb_, fa);
    if (H == 1) {
#pragma unroll
        for (int i = 0; i < 8; ++i) { __builtin_amdgcn_sched_group_barrier(0x008, 1, 0); __builtin_amdgcn_sched_group_barrier(0x100, 2, 0); }
    }
    softmax_half<SHIFT>(sa, negM2, l0, pa);
    asm volatile("" : "+v"(l1) : "v"(l0));
    SBAR();
    s16x4 f0[4], f1[4], f2[4], f3[4];
    v_rd4<H, 0>(f0, vb); v_rd4<H, 1>(f1, vb); v_rd4<H, 2>(f2, vb); v_rd4<H, 3>(f3, vb);
    asm volatile("s_waitcnt lgkmcnt(0)" ::: "memory"); SBAR();
    mid();
    SBAR();
#define PK(L, H_) (bf16x8){L[0], L[1], L[2], L[3], H_[0], H_[1], H_[2], H_[3]}
    const bf16x8 v00 = PK(f0[0], f0[1]), v01 = PK(f0[2], f0[3]), v10 = PK(f1[0], f1[1]), v11 = PK(f1[2], f1[3]);
    const bf16x8 v20 = PK(f2[0], f2[1]), v21 = PK(f2[2], f2[3]), v30 = PK(f3[0], f3[1]), v31 = PK(f3[2], f3[3]);
#undef PK
    o0[0] = __builtin_amdgcn_mfma_f32_32x32x16_bf16(pa[0], v00, o0[0], 0, 0, 0);
    o0[1] = __builtin_amdgcn_mfma_f32_32x32x16_bf16(pa[0], v10, o0[1], 0, 0, 0);
    o0[2] = __builtin_amdgcn_mfma_f32_32x32x16_bf16(pa[0], v20, o0[2], 0, 0, 0);
    o0[3] = __builtin_amdgcn_mfma_f32_32x32x16_bf16(pa[0], v30, o0[3], 0, 0, 0);
    o0[0] = __builtin_amdgcn_mfma_f32_32x32x16_bf16(pa[1], v01, o0[0], 0, 0, 0);
    o0[1] = __builtin_amdgcn_mfma_f32_32x32x16_bf16(pa[1], v11, o0[1], 0, 0, 0);
    o0[2] = __builtin_amdgcn_mfma_f32_32x32x16_bf16(pa[1], v21, o0[2], 0, 0, 0);
    o0[3] = __builtin_amdgcn_mfma_f32_32x32x16_bf16(pa[1], v31, o0[3], 0, 0, 0);
    softmax_half<SHIFT>(sb, negM2, l1, pb);
#pragma unroll
    for (int i = 0; i < 8; ++i) { __builtin_amdgcn_sched_group_barrier(0x008, 1, 0); __builtin_amdgcn_sched_group_barrier(0x402, 6, 0); }
    o1[0] = __builtin_amdgcn_mfma_f32_32x32x16_bf16(pb[0], v00, o1[0], 0, 0, 0);
    o1[1] = __builtin_amdgcn_mfma_f32_32x32x16_bf16(pb[0], v10, o1[1], 0, 0, 0);
    o1[2] = __builtin_amdgcn_mfma_f32_32x32x16_bf16(pb[0], v20, o1[2], 0, 0, 0);
    o1[3] = __builtin_amdgcn_mfma_f32_32x32x16_bf16(pb[0], v30, o1[3], 0, 0, 0);
    o1[0] = __builtin_amdgcn_mfma_f32_32x32x16_bf16(pb[1], v01, o1[0], 0, 0, 0);
    o1[1] = __builtin_amdgcn_mfma_f32_32x32x16_bf16(pb[1], v11, o1[1], 0, 0, 0);
    o1[2] = __builtin_amdgcn_mfma_f32_32x32x16_bf16(pb[1], v21, o1[2], 0, 0, 0);
    o1[3] = __builtin_amdgcn_mfma_f32_32x32x16_bf16(pb[1], v31, o1[3], 0, 0, 0);
}
template <bool SHIFT, class Mid> __device__ __forceinline__ void tile(ldsp Kb, int vb, ldsp Qw, const int (&fa)[4], const bf16x8 (&qa)[4], const bf16x8 (&qb_)[4], float negM2, f32x16 (&o0)[4], f32x16 (&o1)[4], float& l0, float& l1, Mid&& mid) {
    half_tile<SHIFT, 0>(Kb, vb, Qw, fa, qa, qb_, negM2, o0, o1, l0, l1, [] {});
    half_tile<SHIFT, 1>(Kb, vb, Qw, fa, qa, qb_, negM2, o0, o1, l0, l1, mid);
}
__device__ __forceinline__ void epilogue2(f32x16 (&o0)[4], f32x16 (&o1)[4], float l0, float l1, int b, int h, int qb, const Tensors& T, char* lds);

template <bool SHIFT> __device__ __forceinline__ void unit(int b, int h, int qb, const Tensors& T, char* ldsc) {
    int tid = threadIdx.x; asm volatile("" : "+v"(tid));
    const int wid = __builtin_amdgcn_readfirstlane(tid >> 6), lane = tid & 63, r32 = lane & 31, hi = lane >> 5;
    ldsp lds = (ldsp)ldsc;
    const long hb = (long)(b * NH + h) * SEQ;
    const bf16_t* Kh = T.K + hb * 128; const bf16_t* Vh = T.V + hb * 128;
    const unsigned lds0 = (unsigned)(uintptr_t)ldsc;
    const unsigned kdst = lds0 + OFF_K + wid * 2048, vdst = lds0 + OFF_V + wid * 2048;
    unsigned dko[2], dvo[2];
#pragma unroll
    for (int i_ = 0; i_ < 2; ++i_) { const int c_ = wid * 2 + i_;
        const int row_ = 4 * c_ + (lane >> 4), pc_ = lane & 15; dko[i_] = (unsigned)(row_ * 128 + ((pc_ ^ (row_ & 7)) * 8)) * 2u;
        const int s_ = 2 * c_ + (lane >> 5), kk_ = (s_ >> 2) * 8 + ((lane & 31) >> 2), col_ = (s_ & 3) * 32 + (lane & 3) * 8;
        const int k_ = (kk_ & ~0xC) | ((kk_ & 4) << 1) | ((kk_ & 8) >> 1); dvo[i_] = (unsigned)(k_ * 128 + col_) * 2u; }
#define DMA_TILE(t, buf) do { const char* kt_ = (const char*)Kh + (size_t)(t) * 16384; const char* vt_ = (const char*)Vh + (size_t)(t) * 16384; \
        glds16s(dko[0], kt_, kdst + (buf) * SHM); glds16s(dvo[0], vt_, vdst + (buf) * SHM); \
        glds16s(dko[1], kt_, kdst + (buf) * SHM + 1024); glds16s(dvo[1], vt_, vdst + (buf) * SHM + 1024); } while (0)
    DMA_TILE(0, 0);
    ldsp Qw = lds + OFF_Q + wid * 8192;
    { const bf16_t* Qg = T.Q + (hb + qb * 256 + wid * 32) * 128;
      bf16x8 qv[8];
#pragma unroll
      for (int i = 0; i < 8; ++i) qv[i] = *reinterpret_cast<const bf16x8*>(Qg + (i * 4 + (lane >> 4)) * 128 + (lane & 15) * 8);
#pragma unroll
      for (int i = 0; i < 8; ++i) { const int row = i * 4 + (lane >> 4); *(LAS bf16x8*)(Qw + row * 256 + (((lane & 15) * 16) ^ ((row & 7) << 4))) = qv[i]; } }
    const float negM2 = T.negM2;
    float l0 = 0.f, l1 = 0.f; f32x16 o0[4], o1[4];
#pragma unroll
    for (int d = 0; d < 4; ++d) { o0[d] = f32x16{}; o1[d] = f32x16{}; }
    const int vb0 = (int)(uintptr_t)(lds + OFF_V) + v_rd_base(lane);
    int fa[4];
#pragma unroll
    for (int d = 0; d < 4; ++d) fa[d] = r32 * 256 + ((d * 32 + hi * 16) ^ ((r32 & 7) << 4));
#define OPEN_TILE() do { asm volatile("s_waitcnt vmcnt(0) lgkmcnt(0)" ::: "memory"); __builtin_amdgcn_s_barrier(); asm volatile("" ::: "memory"); } while (0)
    OPEN_TILE(); DMA_TILE(1, 1);
    if (wid >= 4) __builtin_amdgcn_s_setprio(1);
    bf16x8 qa[4], qb_[4];
#pragma unroll
    for (int d = 0; d < 4; ++d) { qa[d] = *(const LAS bf16x8*)(Qw + fa[d]); qb_[d] = *(const LAS bf16x8*)(Qw + fa[d] + 128); }
#pragma unroll 1
    for (int t = 0; t < NT; t += 2) {
        tile<SHIFT>(lds + OFF_K, vb0, Qw, fa, qa, qb_, negM2, o0, o1, l0, l1, [&] { OPEN_TILE(); DMA_TILE((t + 2 < NT ? t + 2 : NT - 1), 0); });
        tile<SHIFT>(lds + OFF_K + SHM, vb0 + SHM, Qw, fa, qa, qb_, negM2, o0, o1, l0, l1, [&] { OPEN_TILE(); DMA_TILE((t + 3 < NT ? t + 3 : NT - 1), 1); });
    }
#undef DMA_TILE
#undef OPEN_TILE
    __builtin_amdgcn_s_setprio(0);
    asm volatile("s_waitcnt vmcnt(0) lgkmcnt(0)" ::: "memory"); __builtin_amdgcn_s_barrier(); asm volatile("" ::: "memory");
    epilogue2(o0, o1, l0, l1, b, h, qb, T, ldsc);
}
__device__ __forceinline__ void epilogue2(f32x16 (&o0)[4], f32x16 (&o1)[4], float l0, float l1, int b, int h, int qb, const Tensors& T, char* lds) {
    int tid = threadIdx.x; asm volatile("" : "+v"(tid));
    const int wid = __builtin_amdgcn_readfirstlane(tid >> 6), lane = tid & 63, r32 = lane & 31, hi = lane >> 5;
    float* wsf = (float*)(lds + OFF_WS) + wid * 64;
    { auto rr = __builtin_amdgcn_permlane32_swap(__float_as_uint(l0), __float_as_uint(l0), false, false); l0 = __uint_as_float(rr[0]) + __uint_as_float(rr[1]); }
    { auto rr = __builtin_amdgcn_permlane32_swap(__float_as_uint(l1), __float_as_uint(l1), false, false); l1 = __uint_as_float(rr[0]) + __uint_as_float(rr[1]); }
    if (hi == 0) { wsf[r32] = l0; wsf[32 + r32] = l1; }
    asm volatile("s_waitcnt lgkmcnt(0)" ::: "memory");
    float* X = (float*)(lds + wid * 16384);
    float sw[4];
#pragma unroll
    for (int d = 0; d < 4; ++d) sw[d] = T.subw[d * 32 + r32] * (1.0f - LAM_INIT);
    const float lam = T.lam;
#pragma unroll
    for (int r = 0; r < 16; ++r) {
        const int row = crow(r, hi);
        const float f1 = lam * __builtin_amdgcn_rcpf(wsf[32 + row]);
#pragma unroll
        for (int d = 0; d < 4; ++d) X[row * 128 + d * 32 + r32] = o1[d][r] * f1;
    }
    asm volatile("s_waitcnt lgkmcnt(0)" ::: "memory"); SBAR();
#pragma unroll
    for (int r = 0; r < 16; ++r) {
        const int row = crow(r, hi);
        const float f0 = __builtin_amdgcn_rcpf(wsf[row]);
        float a[4]; float ss = 0.f;
#pragma unroll
        for (int d = 0; d < 4; ++d) { a[d] = o0[d][r] * f0 - X[row * 128 + d * 32 + r32]; ss += a[d] * a[d]; }
        ss += __shfl_xor(ss, 1); ss += __shfl_xor(ss, 2); ss += __shfl_xor(ss, 4); ss += __shfl_xor(ss, 8); ss += __shfl_xor(ss, 16);
        const float rs = 1.0f / sqrtf(ss * (1.0f / 128.0f) + EPSN);
#pragma unroll
        for (int d = 0; d < 4; ++d) X[row * 128 + d * 32 + r32] = a[d] * rs * sw[d];
        SBAR();
    }
    asm volatile("s_waitcnt lgkmcnt(0)" ::: "memory");
    const long grow0 = (long)b * SEQ + qb * 256 + wid * 32;
#pragma unroll
    for (int i = 0; i < 8; ++i) {
        const int idx = i * 64 + lane, row = idx >> 4, ch = idx & 15;
        const f32x4 z0 = *(const f32x4*)(X + row * 128 + ch * 8), z1 = *(const f32x4*)(X + row * 128 + ch * 8 + 4);
        const u32x4 g = *(const u32x4*)(T.GA + (grow0 + row) * AW + h * 128 + ch * 8);
        u32x4 w;
        w.x = cvtpk(z0[0] * bf_lo(g.x), z0[1] * bf_hi(g.x)); w.y = cvtpk(z0[2] * bf_lo(g.y), z0[3] * bf_hi(g.y));
        w.z = cvtpk(z1[0] * bf_lo(g.z), z1[1] * bf_hi(g.z)); w.w = cvtpk(z1[2] * bf_lo(g.w), z1[3] * bf_hi(g.w));
        *(u32x4*)(T.MIX + (grow0 + row) * LDP + h * 128 + ch * 8) = w;
    }
    __syncthreads();
}
}

template <int LO> __device__ __forceinline__ void pool_dg(const unsigned (&raw)[47], bf16_t* dst, int p0) {
    constexpr int HI = LO - 1, DGS = 1032;
    float sx = 0.f, sy = 0.f;
#pragma unroll
    for (int j = 8 - LO; j <= 8 + HI; ++j) { sx += bf_lo(raw[j]); sy += bf_hi(raw[j]); }
#pragma unroll
    for (int i = 0; i < 32; ++i) {
        const int p = p0 + i;
        const int cnt = min(p + HI, SEQ - 1) - max(p - LO, 0) + 1;
        const float rc = 1.0f / (float)cnt;
        *(unsigned*)(dst + i * DGS) = cvtpk(sx * rc - bf_lo(raw[i + 8]), sy * rc - bf_hi(raw[i + 8]));
        if (i < 31) { sx += bf_lo(raw[i + 8 + HI + 1]) - bf_lo(raw[i + 8 - LO]); sy += bf_hi(raw[i + 8 + HI + 1]) - bf_hi(raw[i + 8 - LO]); }
    }
}
__device__ __forceinline__ void pool_job(int blk, const bf16_t* U, const bf16_t* GP, const bf16_t* WPT, const float* pscale, bf16_t* MIX, char* lds) {
    int tid = threadIdx.x; asm volatile("" : "+v"(tid));
    const int wid = __builtin_amdgcn_readfirstlane(tid >> 6), lane = tid & 63, r32 = lane & 31, hi = lane >> 5;
    constexpr int DGS = 1032;
    bf16_t* dgs = (bf16_t*)lds;
    const int t0 = blk * 32, b = t0 / SEQ, p0 = t0 % SEQ;
    {
        const int ch = 2 * tid, g = wid >> 1;
        const bf16_t* base = U + (size_t)b * SEQ * AW + ch;
        unsigned raw[47];
#pragma unroll
        for (int j = 0; j < 47; ++j) { const int p = p0 - 8 + j, pc = min(max(p, 0), SEQ - 1); raw[j] = *(const unsigned*)(base + (size_t)pc * AW); }
#pragma unroll
        for (int j = 0; j < 47; ++j) { const int p = p0 - 8 + j; if (p < 0 || p >= SEQ) raw[j] = 0u; }
        if (g == 0) pool_dg<1>(raw, dgs + ch, p0); else if (g == 1) pool_dg<2>(raw, dgs + ch, p0); else if (g == 2) pool_dg<4>(raw, dgs + ch, p0); else pool_dg<8>(raw, dgs + ch, p0);
    }
    __syncthreads();
    {
        const int g = wid >> 1, nbase = (wid & 1) * 128;
        f32x16 acc[4];
#pragma unroll
        for (int nb = 0; nb < 4; ++nb) acc[nb] = f32x16{};
        const bf16_t* wp = WPT + ((size_t)(g * 256 + nbase + r32) * 256 + hi * 8);
        const bf16_t* ap = dgs + r32 * DGS + g * 256 + hi * 8;
#pragma unroll 4
        for (int ks = 0; ks < 16; ++ks) {
            const bf16x8 a = *reinterpret_cast<const bf16x8*>(ap + ks * 16);
#pragma unroll
            for (int nb = 0; nb < 4; ++nb) {
                const bf16x8 bb = *reinterpret_cast<const bf16x8*>(wp + (size_t)nb * 32 * 256 + ks * 16);
                acc[nb] = __builtin_amdgcn_mfma_f32_32x32x16_bf16(a, bb, acc[nb], 0, 0, 0);
            }
        }
        bf16_t* stg = (bf16_t*)(lds + 66048);
#pragma unroll
        for (int nb = 0; nb < 4; ++nb) {
            const int dg = g * 256 + nbase + nb * 32 + r32;
            const float ps = pscale[dg];
#pragma unroll
            for (int r = 0; r < 16; ++r) { const float y = acc[nb][r] * ps; stg[att::crow(r, hi) * 1024 + dg] = (bf16_t)(cvtpk(y, y) & 0xffffu); }
        }
    }
    __syncthreads();
    {
        const bf16_t* stg = (const bf16_t*)(lds + 66048);
#pragma unroll
        for (int i = 0; i < 8; ++i) {
            const int idx = i * 512 + tid, row = idx >> 7, ch = idx & 127;
            const u32x4 y = *(const u32x4*)(stg + row * 1024 + ch * 8);
            const size_t tok = (size_t)t0 + row;
            const u32x4 gq = *(const u32x4*)(GP + tok * AW + ch * 8);
            u32x4 w;
            w.x = cvtpk(bf_lo(y.x) * bf_lo(gq.x), bf_hi(y.x) * bf_hi(gq.x)); w.y = cvtpk(bf_lo(y.y) * bf_lo(gq.y), bf_hi(y.y) * bf_hi(gq.y));
            w.z = cvtpk(bf_lo(y.z) * bf_lo(gq.z), bf_hi(y.z) * bf_hi(gq.z)); w.w = cvtpk(bf_lo(y.w) * bf_lo(gq.w), bf_hi(y.w) * bf_hi(gq.w));
            *(u32x4*)(MIX + tok * LDP + AW + ch * 8) = w;
        }
    }
    __syncthreads();
}

#define XB_TMO      128
#define XB_XCNT(j)  (256  + 64 * (j))
#define XB_XSUB(j)  (1280 + 64 * (j))
#define XB_XGEN(j)  (2304 + 64 * (j))
#define XB_TOP      3328
#define XB_TOPGEN   3392
#define XCD_BAR_WORDS 3456
#define XB_SPIN_CAP (1u << 18)

__device__ __forceinline__ unsigned xb_ld(unsigned* p)              { return __hip_atomic_load(p, __ATOMIC_RELAXED, __HIP_MEMORY_SCOPE_AGENT); }
__device__ __forceinline__ unsigned xb_add(unsigned* p, unsigned v) { return __hip_atomic_fetch_add(p, v, __ATOMIC_RELAXED, __HIP_MEMORY_SCOPE_AGENT); }
__device__ __forceinline__ unsigned xb_xcc_id() { return (unsigned)__builtin_amdgcn_s_getreg((3 << 11) | 20) & 0xFu; }
#define XB_SPIN(cond, bar) do { unsigned _sp = 0; while (cond) { __builtin_amdgcn_s_sleep(1); \
    if ((++_sp & 255u) == 0u) { if (xb_ld(&(bar)[XB_TMO])) break; if (_sp > XB_SPIN_CAP) { atomicAdd(&(bar)[XB_TMO], 1u); break; } } } } while (0)

struct XcdBarrier {
    unsigned* bar; unsigned x;
    volatile LAS unsigned* st;
};

__device__ __forceinline__ XcdBarrier xcd_barrier_post(unsigned* bar, volatile LAS unsigned* st) {
    XcdBarrier b; b.bar = bar; b.x = xb_xcc_id(); b.st = st;
    if (threadIdx.x == 0) (void)xb_add(&bar[XB_XCNT(b.x)], 1u);
    return b;
}
__device__ __forceinline__ void xcd_barrier_complete(unsigned* bar, unsigned x, unsigned& nloc, unsigned& nx) {
    const unsigned G = gridDim.x * gridDim.y * gridDim.z;
    unsigned sum, cnt, mine, sp = 0u;
    for (;;) {
        sum = 0u; cnt = 0u; mine = 0u;
#pragma unroll
        for (unsigned j = 0; j < 16; ++j) { const unsigned c = xb_ld(&bar[XB_XCNT(j)]); sum += c; cnt += (c > 0u) ? 1u : 0u; mine = (j == x) ? c : mine; }
        if (sum == G) break;
        __builtin_amdgcn_s_sleep(1);
        if ((++sp & 255u) == 0u) { if (xb_ld(&bar[XB_TMO])) break; if (sp > XB_SPIN_CAP) { atomicAdd(&bar[XB_TMO], 1u); break; } }
    }
    nloc = mine > 0u ? mine : 1u; nx = cnt > 0u ? cnt : 1u;
}

__device__ __forceinline__ void xcd_barrier(const XcdBarrier& b) {
    asm volatile("s_waitcnt vmcnt(0)" ::: "memory");
    __syncthreads();
    if (threadIdx.x == 0) {
        unsigned* bar = b.bar;
        __builtin_amdgcn_s_waitcnt(0);
        unsigned nloc = b.st[0], nx = b.st[1];
        if (nloc == 0u) { xcd_barrier_complete(bar, b.x, nloc, nx); b.st[0] = nloc; b.st[1] = nx; }
        const unsigned old = xb_add(&bar[XB_XSUB(b.x)], 1u);
        const unsigned gen = old / nloc;
        if (old + 1u == (gen + 1u) * nloc) {
            __builtin_amdgcn_fence(__ATOMIC_RELEASE, "agent");
            asm volatile("s_waitcnt vmcnt(0)" ::: "memory");
            const unsigned og = xb_add(&bar[XB_TOP], 1u);
            const unsigned tg = og / nx;
            if (og + 1u == (tg + 1u) * nx) xb_add(&bar[XB_TOPGEN], 1u);
            else XB_SPIN(xb_ld(&bar[XB_TOPGEN]) == tg, bar);
            __builtin_amdgcn_fence(__ATOMIC_ACQUIRE, "agent");
            xb_add(&bar[XB_XGEN(b.x)], 1u);
            asm volatile("s_waitcnt vmcnt(0)" ::: "memory");
        } else {
            XB_SPIN(xb_ld(&bar[XB_XGEN(b.x)]) == gen, bar);
            __builtin_amdgcn_fence(__ATOMIC_ACQUIRE, "agent");
            asm volatile("s_waitcnt vmcnt(0)" ::: "memory");
        }
    }
    __syncthreads();
}

struct TItem { const float* W; bf16_t* WT; const float* kscale; int K, N, k0, n0, drow, ldw; };
__device__ __forceinline__ void titem_load(const TItem& t, float (&tv)[32], int lane) {
#pragma unroll
    for (int i = 0; i < 32; ++i) tv[i] = __builtin_nontemporal_load(t.W + (size_t)(t.k0 + 2 * i + (lane >> 5)) * t.N + t.n0 + (lane & 31));
}
__device__ __forceinline__ void titem_finish(const TItem& t, float (&tv)[32], LAS float* scr, int lane) {
    if (t.kscale) {
#pragma unroll
        for (int i = 0; i < 32; ++i) tv[i] *= t.kscale[t.k0 + 2 * i + (lane >> 5)];
    }
#pragma unroll
    for (int i = 0; i < 32; ++i) scr[(2 * i + (lane >> 5)) * 33 + (lane & 31)] = tv[i];
    asm volatile("s_waitcnt lgkmcnt(0)" ::: "memory");
    const int c = lane & 7;
#pragma unroll
    for (int j = 0; j < 4; ++j) { const int n = (lane >> 3) + 8 * j; const LAS float* s = scr + (8 * c) * 33 + n;
        u32x4 o; o.x = cvtpk(s[0 * 33], s[1 * 33]); o.y = cvtpk(s[2 * 33], s[3 * 33]); o.z = cvtpk(s[4 * 33], s[5 * 33]); o.w = cvtpk(s[6 * 33], s[7 * 33]);
        *(u32x4*)(t.WT + (size_t)(t.drow + n) * t.ldw + t.k0 + 8 * c) = o; }
    asm volatile("s_waitcnt lgkmcnt(0)" ::: "memory");
}

struct Args {
    const float* in[13]; float* out; unsigned char* ws;
    double turns[8];
    int ph_lo, ph_hi;
};

__global__ void __launch_bounds__(512, 2) mega_fwd(Args args) {
    extern __shared__ __attribute__((aligned(16))) unsigned char lds[];
    const int tid = threadIdx.x, lane = tid & 63, wave = __builtin_amdgcn_readfirstlane(tid >> 6);
    const int G = gridDim.x, bx = blockIdx.x;
    const int vcu = (G % 8 == 0) ? (bx % 8) * (G / 8) + bx / 8 : bx;
    unsigned char* ws = args.ws;
    const float* x = args.in[0]; const float* norm_w = args.in[1]; const float* w_in = args.in[2]; const float* qnw = args.in[3]; const float* knw = args.in[4];
    const float* lq1 = args.in[5]; const float* lk1 = args.in[6]; const float* lq2 = args.in[7]; const float* lk2 = args.in[8];
    const float* subw = args.in[9]; const float* w_pool = args.in[10]; const float* pscale = args.in[11]; const float* w_out = args.in[12];
    float* ROPE = (float*)(ws + WS_ROPE);
    bf16_t* WPT = (bf16_t*)(ws + WS_WPT); bf16_t* WIT = (bf16_t*)(ws + WS_WIT); bf16_t* WOT = (bf16_t*)(ws + WS_WOT); bf16_t* XS = (bf16_t*)(ws + WS_XS);
    bf16_t* QB = (bf16_t*)(ws + WS_Q); bf16_t* KB = (bf16_t*)(ws + WS_K); bf16_t* VB = (bf16_t*)(ws + WS_V);
    bf16_t* GA = (bf16_t*)(ws + WS_GA); bf16_t* UB = (bf16_t*)(ws + WS_U); bf16_t* GP = (bf16_t*)(ws + WS_GP); bf16_t* MIX = (bf16_t*)(ws + WS_MIX);
    const int lo = args.ph_lo, hi = args.ph_hi;
    volatile LAS unsigned* MISC = (volatile LAS unsigned*)((LAS unsigned char*)lds + 133120);
    if (tid < 2) MISC[tid] = 0u;
    __syncthreads();
    XcdBarrier bar = xcd_barrier_post((unsigned*)(ws + WS_CTL), MISC);
#ifdef ONLY_PHASE
#define IN(k) ((k) == ONLY_PHASE && lo <= (k) && (k) < hi)
#else
#define IN(k) (lo <= (k) && (k) < hi)
#endif
#define SEAM(k) do { if (IN(k) && IN((k) + 1)) { if ((k) == 0) cg::this_grid().sync(); else xcd_barrier(bar); } } while (0)

    if (IN(0)) {
        LAS float* scr = (LAS float*)((LAS unsigned char*)lds + wave * 16384);
        const int gw = vcu * 8 + wave, NGW = G * 8;
        constexpr int I_IN = (DM / 64) * (NIN / 32), I_OUT = (DM / 64) * (DM / 32), I_P = 4 * (256 / 64) * (256 / 32);
        auto decode = [&](int it) -> TItem {
            TItem t; int r = it;
            if (r < I_IN) { const int nblk = NIN / 32, kb = r / nblk, nb = r % nblk, n0 = nb * 32, a = n0 & 255;
                t.W = w_in; t.WT = WIT; t.kscale = norm_w; t.K = DM; t.ldw = LDP; t.N = NIN; t.k0 = kb * 64; t.n0 = n0; t.drow = (n0 & ~255) + ((a >> 5) & 1) * 128 + (a >> 6) * 32; return t; }
            r -= I_IN;
            if (r < I_OUT) { const int nblk = DM / 32, kb = r / nblk, nb = r % nblk;
                t.W = w_out; t.WT = WOT; t.kscale = nullptr; t.K = DM; t.ldw = LDP; t.N = DM; t.k0 = kb * 64; t.n0 = nb * 32; t.drow = nb * 32; return t; }
            r -= I_OUT;
            { const int g = r / 32, rr = r % 32, kb = rr / 8, nb = rr % 8;
              t.W = w_pool + (size_t)g * 65536; t.WT = WPT + (size_t)g * 65536; t.kscale = nullptr; t.K = 256; t.ldw = 256; t.N = 256; t.k0 = kb * 64; t.n0 = nb * 32; t.drow = nb * 32; return t; }
        };
        constexpr int NIT = I_IN + I_OUT + I_P;
        for (int it = gw; it < NIT; it += 2 * NGW) {
            const int it1 = it + NGW; const bool two = it1 < NIT;
            const TItem ta = decode(it), tb = decode(two ? it1 : it);
            float va[32], vb[32];
            titem_load(ta, va, lane);
            if (two) titem_load(tb, vb, lane);
            titem_finish(ta, va, scr, lane);
            if (two) titem_finish(tb, vb, scr, lane);
        }
        for (int m = gw; m < MTOK; m += 2 * NGW) {
            const int m2 = (m + NGW < MTOK) ? m + NGW : m;
            const f32x4* xr0 = (const f32x4*)(x + (size_t)m * DM) + lane; const f32x4* xr1 = (const f32x4*)(x + (size_t)m2 * DM) + lane;
            f32x4 v[8], w2[8]; float s0 = 0.f, s1 = 0.f;
#pragma unroll
            for (int j = 0; j < 8; ++j) { v[j] = __builtin_nontemporal_load(xr0 + 64 * j); w2[j] = __builtin_nontemporal_load(xr1 + 64 * j); }
#pragma unroll
            for (int j = 0; j < 8; ++j) { s0 += (v[j].x * v[j].x + v[j].y * v[j].y) + (v[j].z * v[j].z + v[j].w * v[j].w); s1 += (w2[j].x * w2[j].x + w2[j].y * w2[j].y) + (w2[j].z * w2[j].z + w2[j].w * w2[j].w); }
            const float r0 = 1.0f / sqrtf(wave_sum(s0) * (1.0f / DM) + EPSN), r1 = 1.0f / sqrtf(wave_sum(s1) * (1.0f / DM) + EPSN);
            u32x2* o0 = (u32x2*)(XS + (size_t)m * LDP) + lane; u32x2* o1 = (u32x2*)(XS + (size_t)m2 * LDP) + lane;
#pragma unroll
            for (int j = 0; j < 8; ++j) { u32x2 w; w.x = cvtpk(v[j].x * r0, v[j].y * r0); w.y = cvtpk(v[j].z * r0, v[j].w * r0); o0[64 * j] = w;
                                          u32x2 y; y.x = cvtpk(w2[j].x * r1, w2[j].y * r1); y.y = cvtpk(w2[j].z * r1, w2[j].w * r1); o1[64 * j] = y; }
        }
        for (int e = (vcu * 512 + tid); e < SEQ * 8; e += G * 512) {
            const int pos = e >> 3, i = e & 7;
            const double t = (double)pos * args.turns[i];
            const float fr = (float)(t - floor(t));
            ROPE[pos * 16 + i] = __builtin_amdgcn_cosf(fr);
            ROPE[pos * 16 + 8 + i] = __builtin_amdgcn_sinf(fr);
        }
    }
    SEAM(0);

    if (IN(1)) {
        pg8::Gemm g{XS, WIT, MTOK, NIN, DM, LDP}; pg8::StaticOrder S; S.init(MTOK, NIN, G, bx);
        EpiProj E{QB, KB, VB, GA, UB, GP, qnw, knw, ROPE, 0.125f * LOG2E};
        pg8::gemm_phase<EpiProj, pg8::StaticOrder, true, true>((LAS unsigned char*)lds, g, S, E);
    }
    SEAM(1);

    if (IN(2)) {
        const float d1 = wave_sum(lq1[lane] * lk1[lane]), d2 = wave_sum(lq2[lane] * lk2[lane]);
        const float lam = __expf(d1) - __expf(d2) + LAM_INIT;
        const float mq = wave_max(fabsf(qnw[lane])), mk = wave_max(fabsf(knw[lane]));
        const float M2 = 8.0f * mq * mk * LOG2E * 1.02f;
        const float lam_s = __uint_as_float(__builtin_amdgcn_readfirstlane(__float_as_uint(lam)));
        const float nm2_s = __uint_as_float(__builtin_amdgcn_readfirstlane(__float_as_uint(-M2)));
        att::Tensors T{QB, KB, VB, GA, MIX, subw, lam_s, nm2_s};
        for (int u = vcu; u < 256; u += G) { const int bh = u >> 4, qb = u & 15;
            if (nm2_s < -40.0f) att2::unit<true>(bh >> 3, bh & 7, qb, T, (char*)lds); else att2::unit<false>(bh >> 3, bh & 7, qb, T, (char*)lds); }
        for (int blk = vcu; blk < MTOK / 32; blk += G) pool_job(blk, UB, GP, WPT, pscale, MIX, (char*)lds);
    }
    SEAM(2);

    if (IN(3)) {
        pg8::Gemm g{MIX, WOT, MTOK, DM, DM, LDP}; pg8::StaticOrder S; S.init(MTOK, DM, G, bx);
        EpiOut E{x, args.out};
        pg8::gemm_phase<EpiOut, pg8::StaticOrder, true, true>((LAS unsigned char*)lds, g, S, E);
    }
#undef IN
#undef SEAM
}

constexpr int LDS_BYTES = 135168;
extern "C" void kernel_launch(void* const* d_in, const int* in_sizes, int n_in, void* d_out, int out_size, void* d_ws, size_t ws_size, hipStream_t stream) {
    static int grid = 0;
    if (grid == 0) {
        if (n_in != 13 || in_sizes[0] != MTOK * DM || out_size != MTOK * DM || ws_size < WS_END) { fprintf(stderr, "kernel_launch: unexpected shapes\n"); grid = -1; return; }
        int dev = 0, cus = 0, per_cu = 0;
        (void)hipGetDevice(&dev);
        (void)hipDeviceGetAttribute(&cus, hipDeviceAttributeMultiprocessorCount, dev);
        if (hipFuncSetAttribute((const void*)mega_fwd, hipFuncAttributeMaxDynamicSharedMemorySize, LDS_BYTES) != hipSuccess) { fprintf(stderr, "kernel_launch: hipFuncSetAttribute failed\n"); grid = -1; return; }
        if (hipOccupancyMaxActiveBlocksPerMultiprocessor(&per_cu, (const void*)mega_fwd, 512, LDS_BYTES) != hipSuccess || per_cu < 1) { fprintf(stderr, "kernel_launch: occupancy query failed (%d)\n", per_cu); per_cu = 1; }
        (void)hipGetLastError();
        grid = cus * (per_cu > 1 ? 1 : per_cu);
        if (grid > 256) grid = 256;
    }
    if (grid < 0) return;
    Args a{};
    for (int i = 0; i < 13; ++i) a.in[i] = (const float*)d_in[i];
    a.out = (float*)d_out; a.ws = (unsigned char*)d_ws;
    for (int i = 0; i < 8; ++i) a.turns[i] = std::pow(500000.0, -(double)(2 * i) / 16.0) / 6.283185307179586476925;
    constexpr int NL = MK_N_LAUNCHES;
    (void)hipMemsetAsync((char*)d_ws + WS_CTL, 0, CTL_BYTES, stream);
    if (NL == 1) {
        a.ph_lo = 0; a.ph_hi = 4;
        void* kargs[] = {&a};
        hipError_t e = hipLaunchCooperativeKernel((const void*)mega_fwd, dim3(grid), dim3(512), kargs, LDS_BYTES, stream);
        if (e != hipSuccess) fprintf(stderr, "cooperative launch failed: %s (grid %d)\n", hipGetErrorString(e), grid);
        if (PROBE_EXTRA_PHASE >= 0) { a.ph_lo = PROBE_EXTRA_PHASE; a.ph_hi = PROBE_EXTRA_PHASE + 1; hipLaunchKernelGGL(mega_fwd, dim3(grid), dim3(512), LDS_BYTES, stream, a); }
    } else {
        for (int p = 0; p < 4; ++p) { a.ph_lo = p; a.ph_hi = p + 1; hipLaunchKernelGGL(mega_fwd, dim3(grid), dim3(512), LDS_BYTES, stream, a); }
    }
}
```

```cpp
#include <hip/hip_runtime.h>
#include <hip/hip_cooperative_groups.h>
#include <hip/hip_bf16.h>
#include <cstdio>
#include <cstdint>
#include <cmath>
namespace cg = cooperative_groups;

#ifndef PROBE_EXTRA_PHASE
#define PROBE_EXTRA_PHASE -1
#endif
#ifndef MK_N_LAUNCHES
#define MK_N_LAUNCHES 1
#endif

namespace pg8 {
#define PG8_LAS __attribute__((address_space(3)))
typedef unsigned short bf16_t;
typedef short bf16x8 __attribute__((ext_vector_type(8)));
typedef float f32x4 __attribute__((ext_vector_type(4)));
typedef unsigned u32x4 __attribute__((ext_vector_type(4)));
constexpr int BM = 256, BK = 64, HALF = 128, HTB = HALF * BK * 2  , STAGE_BYTES = 8 * HTB, NXCD = 8, WGM = 8;

__host__ __device__ __forceinline__ int lds_byte(int r, int c) { const int st = (r >> 4) * 2 + (c >> 5), rr = r & 15, cc = c & 31, ob = rr * 64 + cc * 2; return st * 1024 + (ob ^ (((ob >> 9) & 1) << 5)); }
__host__ __device__ __forceinline__ void stage_rc(int b, int& R, int& C) { const int st = b / 1024, sb = b % 1024, swz = sb ^ (((sb >> 9) & 1) << 5); R = (st >> 1) * 16 + swz / 64; C = (st & 1) * 32 + (swz % 64) / 2; }
__host__ __device__ __forceinline__ int perm32(int rho) { const int n = rho >> 4, i = rho & 15; return 8 * (i >> 2) + 4 * n + (i & 3); }

struct Unit { int pm, pn; };
struct Gemm { const bf16_t* A; const bf16_t* Bt; int M, N, K, ld; };

struct StaticOrder {
    int nM, nN, nwg, G, c;
    __host__ __device__ void init(int M, int N, int G_, int c_) { nM = M / BM; nN = N / BM; nwg = nM * nN; G = G_; c = c_; }
    __host__ __device__ bool next(int i, Unit& u) const {
        const long L = (long)i * G + c; if (L >= nwg) return false;
        int wgid = (int)L; { const int q = nwg / NXCD, r = nwg % NXCD, xcd = wgid % NXCD, off = wgid / NXCD; wgid = (xcd < r ? xcd * (q + 1) : r * (q + 1) + (xcd - r) * q) + off; }
        const int nig = WGM * nN, gid = wgid / nig, fm = gid * WGM, gsz = (nM - fm) < WGM ? (nM - fm) : WGM;
        u.pm = fm + ((wgid % nig) % gsz); u.pn = (wgid % nig) / gsz; return true;
    }
    __device__ __forceinline__ void a_ready(const Unit&) const {}
    __device__ __forceinline__ void done(const Unit&) const {}
};

__device__ __forceinline__ unsigned cvt_pk_bf16(float lo, float hi) { unsigned r; asm volatile("v_cvt_pk_bf16_f32 %0, %1, %2" : "=v"(r) : "v"(lo), "v"(hi)); return r; }
template <class Epi, class Sched, bool ALIGN_EPI = false, bool SP2 = false>
__device__ __forceinline__ void gemm_phase(PG8_LAS unsigned char* lds, const Gemm g, const Sched& S, const Epi& E) {
    int tid = threadIdx.x; asm volatile("" : "+v"(tid));
    const int wid = __builtin_amdgcn_readfirstlane(tid >> 6), lane = tid & 63, wr = wid >> 2, wc = wid & 3, fr = lane & 15, fq = lane >> 4;
    const int K = g.K, nt = K / BK;
    unsigned voffA[2], voffB[2];
#pragma unroll
    for (int i = 0; i < 2; ++i) { int R, C; stage_rc(tid * 16 + i * 8192, R, C); const int Rb = Epi::PERM ? ((R & ~31) + perm32(R & 31)) : R;
        voffA[i] = (unsigned)(R * g.ld + C) * 2u; voffB[i] = (unsigned)(Rb * g.ld + C) * 2u; }
    const size_t kstep = (size_t)(BK * 2);
    const size_t hstep = (size_t)HALF * g.ld * 2;
    const size_t tstep = 2 * hstep;
    const unsigned ldsw = (unsigned)wid * 1024u;
    const int aoff = lds_byte(wr * 64 + fr, fq * 8), boff = lds_byte(wc * 32 + fr, fq * 8);
#define PG8_SA(b, h) (((b) * 2 + (h)) * HTB)
#define PG8_SB(b, h) ((4 + (b) * 2 + (h)) * HTB)
#define PG8_STAGE(bufoff, gbase, voff) do { _Pragma("unroll") for (int _i = 0; _i < 2; ++_i) \
        __builtin_amdgcn_global_load_lds((const unsigned*)((const char*)(gbase) + (voff)[_i]), (PG8_LAS unsigned*)(lds + (bufoff) + ldsw + _i * 8192), 16, 0, 0); } while (0)
#define PG8_LDA(dst, b, h) do { _Pragma("unroll") for (int m = 0; m < 4; ++m) _Pragma("unroll") for (int k = 0; k < 2; ++k) dst[m][k] = *(const PG8_LAS bf16x8*)(lds + PG8_SA(b, h) + aoff + m * 2048 + k * 1024); } while (0)
#define PG8_LDB(dst, b, h) do { _Pragma("unroll") for (int n = 0; n < 2; ++n) _Pragma("unroll") for (int k = 0; k < 2; ++k) dst[n][k] = *(const PG8_LAS bf16x8*)(lds + PG8_SB(b, h) + boff + n * 2048 + k * 1024); } while (0)
#define PG8_MMA(ai, bj, At, Bt) do { __builtin_amdgcn_s_setprio(1); _Pragma("unroll") for (int m = 0; m < 4; ++m) _Pragma("unroll") for (int n = 0; n < 2; ++n) _Pragma("unroll") for (int k = 0; k < 2; ++k) \
        acc[ai][bj][m][n] = __builtin_amdgcn_mfma_f32_16x16x32_bf16(Bt[n][k], At[m][k], acc[ai][bj][m][n], 0, 0, 0); __builtin_amdgcn_s_setprio(0); } while (0)
#define PG8_WAIT_V(n) asm volatile("s_waitcnt vmcnt(" #n ")" ::: "memory")
#define PG8_WAIT_L(n) asm volatile("s_waitcnt lgkmcnt(" #n ")" ::: "memory")
#define PG8_BAR __builtin_amdgcn_s_barrier()
#define PG8_SCHED __builtin_amdgcn_sched_barrier(0)
    Unit cur, nxt; int ui = 0;
    if (!S.next(0, cur)) return;
    f32x4 acc[2][2][4][2];
    if constexpr (Epi::INIT) E.init(acc, cur, wr, wc, fr, fq);
    else {
#pragma unroll
    for (int a = 0; a < 2; ++a)
#pragma unroll
        for (int b = 0; b < 2; ++b)
#pragma unroll
            for (int m = 0; m < 4; ++m)
#pragma unroll
                for (int n = 0; n < 2; ++n) acc[a][b][m][n] = (f32x4){0.f, 0.f, 0.f, 0.f};
    }
    bf16x8 At[4][2], B0[2][2], B1[2][2];
    const char* cA = (const char*)g.A + (size_t)cur.pm * tstep; const char* cB = (const char*)g.Bt + (size_t)cur.pn * tstep;
    S.a_ready(cur);
    if constexpr (SP2) {
        PG8_STAGE(PG8_SB(0, 0), cB, voffB); PG8_STAGE(PG8_SB(0, 1), cB + hstep, voffB); PG8_STAGE(PG8_SA(0, 0), cA, voffA); PG8_STAGE(PG8_SA(0, 1), cA + hstep, voffA);
        if (wr == 1) PG8_BAR;
        PG8_WAIT_V(2); PG8_BAR;
        PG8_STAGE(PG8_SB(1, 0), cB + kstep, voffB); PG8_STAGE(PG8_SA(1, 0), cA + kstep, voffA); PG8_STAGE(PG8_SB(1, 1), cB + hstep + kstep, voffB);
        PG8_WAIT_V(6); PG8_BAR;
    } else {
        PG8_STAGE(PG8_SB(0, 0), cB, voffB); PG8_STAGE(PG8_SA(0, 0), cA, voffA); PG8_STAGE(PG8_SB(0, 1), cB + hstep, voffB); PG8_STAGE(PG8_SA(0, 1), cA + hstep, voffA);
        if (wr == 1) PG8_BAR;
        PG8_WAIT_V(4); PG8_BAR;
        PG8_STAGE(PG8_SB(1, 0), cB + kstep, voffB); PG8_STAGE(PG8_SA(1, 0), cA + kstep, voffA); PG8_STAGE(PG8_SB(1, 1), cB + hstep + kstep, voffB);
        PG8_WAIT_V(6); PG8_BAR;
    }
    for (;;) {
        const bool has_next = S.next(ui + 1, nxt);
        const char* nA = has_next ? (const char*)g.A + (size_t)nxt.pm * tstep : cA; const char* nB = has_next ? (const char*)g.Bt + (size_t)nxt.pn * tstep : cB;
        for (int t = 0; t < nt; t += 2) {
            const bool last = (t == nt - 2);
            const char* a1 = cA + (size_t)(t + 1) * kstep;
            const char* a2 = last ? nA : cA + (size_t)(t + 2) * kstep; const char* b2 = last ? nB : cB + (size_t)(t + 2) * kstep;
            const char* a3 = a2 + kstep; const char* b3 = b2 + kstep;
            if (last && has_next) S.a_ready(nxt);
            if constexpr (SP2) {
            PG8_LDB(B0, 0, 0); PG8_LDB(B1, 0, 1); PG8_SCHED; PG8_LDA(At, 0, 0); PG8_STAGE(PG8_SA(1, 1), a1 + hstep, voffA);
            PG8_WAIT_V(8); PG8_WAIT_L(0); PG8_BAR; PG8_MMA(0, 0, At, B0); PG8_MMA(0, 1, At, B1); PG8_BAR; PG8_SCHED;
            PG8_LDA(At, 0, 1); PG8_STAGE(PG8_SB(0, 0), b2, voffB); PG8_STAGE(PG8_SB(0, 1), b2 + hstep, voffB); PG8_STAGE(PG8_SA(0, 0), a2, voffA);
            PG8_WAIT_V(8); PG8_WAIT_L(0); PG8_BAR; PG8_MMA(1, 0, At, B0); PG8_MMA(1, 1, At, B1); PG8_BAR; PG8_SCHED;
            PG8_LDB(B0, 1, 0); PG8_LDB(B1, 1, 1); PG8_SCHED; PG8_LDA(At, 1, 0); PG8_STAGE(PG8_SA(0, 1), a2 + hstep, voffA);
            PG8_WAIT_V(8); PG8_WAIT_L(0); PG8_BAR; PG8_MMA(0, 0, At, B0); PG8_MMA(0, 1, At, B1); PG8_BAR; PG8_SCHED;
            PG8_LDA(At, 1, 1); PG8_STAGE(PG8_SB(1, 0), b3, voffB); PG8_STAGE(PG8_SB(1, 1), b3 + hstep, voffB); PG8_STAGE(PG8_SA(1, 0), a3, voffA);
            PG8_WAIT_V(8); PG8_WAIT_L(0); PG8_BAR; PG8_MMA(1, 0, At, B0); PG8_MMA(1, 1, At, B1); PG8_BAR; PG8_SCHED;
            } else {
            PG8_LDB(B0, 0, 0); PG8_SCHED; PG8_LDA(At, 0, 0); PG8_STAGE(PG8_SA(1, 1), a1 + hstep, voffA);
            PG8_WAIT_L(8); PG8_BAR; PG8_WAIT_L(0); PG8_MMA(0, 0, At, B0); PG8_BAR; PG8_SCHED;
            PG8_LDB(B1, 0, 1); PG8_STAGE(PG8_SB(0, 0), b2, voffB);
            PG8_BAR; PG8_WAIT_L(0); PG8_MMA(0, 1, At, B1); PG8_BAR;
            PG8_LDA(At, 0, 1); PG8_STAGE(PG8_SA(0, 0), a2, voffA);
            PG8_BAR; PG8_WAIT_L(0); PG8_MMA(1, 0, At, B0); PG8_BAR; PG8_SCHED;
            PG8_STAGE(PG8_SB(0, 1), b2 + hstep, voffB);
            PG8_WAIT_V(6); PG8_BAR; PG8_MMA(1, 1, At, B1); PG8_BAR;
            PG8_LDB(B0, 1, 0); PG8_SCHED; PG8_LDA(At, 1, 0); PG8_STAGE(PG8_SA(0, 1), a2 + hstep, voffA);
            PG8_WAIT_L(8); PG8_BAR; PG8_WAIT_L(0); PG8_MMA(0, 0, At, B0); PG8_BAR; PG8_SCHED;
            PG8_LDB(B1, 1, 1); PG8_STAGE(PG8_SB(1, 0), b3, voffB);
            PG8_BAR; PG8_WAIT_L(0); PG8_MMA(0, 1, At, B1); PG8_BAR;
            PG8_LDA(At, 1, 1); PG8_STAGE(PG8_SA(1, 0), a3, voffA);
            PG8_BAR; PG8_WAIT_L(0); PG8_MMA(1, 0, At, B0); PG8_BAR; PG8_SCHED;
            PG8_STAGE(PG8_SB(1, 1), b3 + hstep, voffB);
            PG8_WAIT_V(6); PG8_BAR; PG8_MMA(1, 1, At, B1); PG8_BAR;
            }
        }
        if constexpr (ALIGN_EPI) { if (wr == 0) PG8_BAR; }
        if constexpr (!Epi::AFTER_DRAIN) { E(acc, cur, wr, wc, fr, fq); S.done(cur); }
        if (!has_next) break;
        if constexpr (Epi::INIT) E.init(acc, nxt, wr, wc, fr, fq);
        else {
#pragma unroll
        for (int a = 0; a < 2; ++a)
#pragma unroll
            for (int b = 0; b < 2; ++b)
#pragma unroll
                for (int m = 0; m < 4; ++m)
#pragma unroll
                    for (int n = 0; n < 2; ++n) acc[a][b][m][n] = (f32x4){0.f, 0.f, 0.f, 0.f};
        }
        cur = nxt; cA = nA; cB = nB; ++ui;
        if constexpr (ALIGN_EPI) { if (wr == 1) PG8_BAR; }
    }
    PG8_WAIT_V(0);
    if constexpr (!ALIGN_EPI) { if (wr == 0) PG8_BAR; }
    PG8_BAR;
    if constexpr (Epi::AFTER_DRAIN) { E.fused(acc, cur, wr, wc, fr, fq, lds, wid, lane); S.done(cur); }
#undef PG8_SA
#undef PG8_SB
#undef PG8_STAGE
#undef PG8_LDA
#undef PG8_LDB
#undef PG8_MMA
#undef PG8_WAIT_V
#undef PG8_WAIT_L
#undef PG8_BAR
#undef PG8_SCHED
}
}

constexpr int BATCH = 2, SEQ = 4096, DM = 2048, MTOK = BATCH * SEQ;
constexpr int AW = 1024, PW = 1024, NIN = 6144, HD = 64, NH = 8;
constexpr float EPSN = 1e-6f;
constexpr float LAM_INIT = 0.2f;
constexpr float LOG2E = 1.4426950408889634f;

constexpr size_t MiB = 1u << 20;
constexpr size_t WS_ROPE = 0;
constexpr size_t WS_CTL = 512 * 1024, CTL_BYTES = 16384;
constexpr size_t WS_WPT = 1 * MiB;
constexpr int LDP = DM + 64;
constexpr size_t WS_WIT = 2 * MiB;
constexpr size_t WS_WOT = 27 * MiB;
constexpr size_t WS_XS = 36 * MiB;
constexpr size_t WS_Q = 70 * MiB, WS_K = 86 * MiB, WS_V = 102 * MiB, WS_GA = 118 * MiB, WS_U = 134 * MiB, WS_GP = 150 * MiB;
constexpr size_t WS_MIX = 166 * MiB;
constexpr size_t WS_END = 200 * MiB;
static_assert(WS_WIT + (size_t)6144 * LDP * 2 <= WS_WOT && WS_WOT + (size_t)2048 * LDP * 2 <= WS_XS && WS_XS + (size_t)8192 * LDP * 2 <= WS_Q && WS_MIX + (size_t)8192 * LDP * 2 <= WS_END, "d_ws map");

#define LAS __attribute__((address_space(3)))
typedef unsigned short bf16_t;
typedef float f32x4 __attribute__((ext_vector_type(4)));
typedef float f32x2 __attribute__((ext_vector_type(2)));
typedef unsigned u32x4 __attribute__((ext_vector_type(4)));
typedef unsigned u32x2 __attribute__((ext_vector_type(2)));
typedef short bf16x8 __attribute__((ext_vector_type(8)));
typedef short s16x4 __attribute__((ext_vector_type(4)));
typedef float f32x16 __attribute__((ext_vector_type(16)));

typedef __bf16 bf16x2_cv __attribute__((ext_vector_type(2)));
__device__ __forceinline__ unsigned cvtpk(float lo, float hi) { f32x2 v = {lo, hi}; bf16x2_cv b = __builtin_convertvector(v, bf16x2_cv); return __builtin_bit_cast(unsigned, b); }
__device__ __forceinline__ float bf_lo(unsigned w) { return __uint_as_float(w << 16); }
__device__ __forceinline__ float bf_hi(unsigned w) { return __uint_as_float(w & 0xffff0000u); }
__device__ __forceinline__ float silu_f(float x) { return x * __builtin_amdgcn_rcpf(1.0f + __builtin_amdgcn_exp2f(-x * LOG2E)); }
__device__ __forceinline__ float wave_sum(float v) {
#pragma unroll
    for (int o = 1; o < 64; o <<= 1) v += __shfl_xor(v, o);
    return v;
}
__device__ __forceinline__ float wave_max(float v) {
#pragma unroll
    for (int o = 1; o < 64; o <<= 1) v = fmaxf(v, __shfl_xor(v, o));
    return v;
}

struct EpiProj {
    static constexpr bool PERM = true, AFTER_DRAIN = false, INIT = false;
    bf16_t *Q, *K, *V, *GA, *U, *GP; const float *qw, *kw; const float* rope; float qscale;
    __device__ __forceinline__ void operator()(const f32x4 (&acc)[2][2][4][2], const pg8::Unit& u, int wr, int wc, int fr, int fq) const {
        const int type = u.pn >> 2;
        const int col0 = (u.pn & 3) * 256 + wc * 64 + fq * 8;
        const int row0 = u.pm * 256 + wr * 64 + fr;
        if (type <= 1) {
            const float* wsrc = (type == 0 ? qw : kw) + fq * 8;
            const f32x4 w00 = *(const f32x4*)(wsrc), w01 = *(const f32x4*)(wsrc + 4), w10 = *(const f32x4*)(wsrc + 32), w11 = *(const f32x4*)(wsrc + 36);
            bf16_t* dsth = (type == 0 ? Q : K) + (size_t)(((u.pm * 256) >> 12) * NH + (col0 >> 7)) * SEQ * 128 + (col0 & 127);
            const float sc = (type == 0) ? qscale : 1.0f;
            const float sgn = (fq == 0) ? -1.0f : 1.0f;
#pragma unroll
            for (int ai = 0; ai < 2; ++ai) {
                f32x4 rc[4][4];
#pragma unroll
                for (int m = 0; m < 4; ++m) { const float* rp = rope + ((row0 + ai * 128 + m * 16) & (SEQ - 1)) * 16;
#pragma unroll
                    for (int q = 0; q < 4; ++q) rc[m][q] = (fq < 2) ? *(const f32x4*)(rp + 4 * q) : (f32x4){0.f, 0.f, 0.f, 0.f}; }
                asm volatile("" ::: "memory");
#pragma unroll
                for (int m = 0; m < 4; ++m) {
                    const int row = row0 + ai * 128 + m * 16, pos = row & (SEQ - 1);
                    f32x4 v00 = acc[ai][0][m][0], v01 = acc[ai][0][m][1], v10 = acc[ai][1][m][0], v11 = acc[ai][1][m][1];
                    float ss = (v00[0] * v00[0] + v00[1] * v00[1]) + (v00[2] * v00[2] + v00[3] * v00[3]);
                    ss += (v01[0] * v01[0] + v01[1] * v01[1]) + (v01[2] * v01[2] + v01[3] * v01[3]);
                    ss += (v10[0] * v10[0] + v10[1] * v10[1]) + (v10[2] * v10[2] + v10[3] * v10[3]);
                    ss += (v11[0] * v11[0] + v11[1] * v11[1]) + (v11[2] * v11[2] + v11[3] * v11[3]);
                    ss += __shfl_xor(ss, 16); ss += __shfl_xor(ss, 32);
                    const float rs = 1.0f / sqrtf(ss * (1.0f / 64.0f) + EPSN);
                    v00 = v00 * rs * w00; v01 = v01 * rs * w01; v10 = v10 * rs * w10; v11 = v11 * rs * w11;
                    f32x4 o00, o01;
#pragma unroll
                    for (int i = 0; i < 4; ++i) { o00[i] = __shfl_xor(v00[i], 16); o01[i] = __shfl_xor(v01[i], 16); }
                    if (fq < 2) {
                        const f32x4 c0 = rc[m][0], c1 = rc[m][1], s0 = rc[m][2], s1 = rc[m][3];
                        v00 = v00 * c0 + (o00 * s0) * sgn; v01 = v01 * c1 + (o01 * s1) * sgn;
                    }
                    v00 = v00 * sc; v01 = v01 * sc; v10 = v10 * sc; v11 = v11 * sc;
                    u32x4 a, b;
                    a.x = cvtpk(v00[0], v00[1]); a.y = cvtpk(v00[2], v00[3]); a.z = cvtpk(v01[0], v01[1]); a.w = cvtpk(v01[2], v01[3]);
                    b.x = cvtpk(v10[0], v10[1]); b.y = cvtpk(v10[2], v10[3]); b.z = cvtpk(v11[0], v11[1]); b.w = cvtpk(v11[2], v11[3]);
                    bf16_t* rowp = dsth + (size_t)pos * 128;
                    *(u32x4*)(rowp) = a; *(u32x4*)(rowp + 32) = b;
                }
                asm volatile("" ::: "memory");
            }
        } else {
            bf16_t* dst = (type == 2) ? V : (type == 3) ? GA : (type == 4) ? U : GP;
            const bool act = (type == 3) || (type == 5);
            const bool hm = (type == 2);
            const int rstride = hm ? 128 : AW, rmask = hm ? (SEQ - 1) : 0x7fffffff;
            dst += hm ? (size_t)(((u.pm * 256) >> 12) * NH + (col0 >> 7)) * SEQ * 128 + (col0 & 127) : (size_t)col0;
#pragma unroll
            for (int ai = 0; ai < 2; ++ai)
#pragma unroll
                for (int m = 0; m < 4; ++m) {
                    const int row = row0 + ai * 128 + m * 16;
                    bf16_t* rowp = dst + (size_t)(row & rmask) * rstride;
#pragma unroll
                    for (int bj = 0; bj < 2; ++bj) {
                        f32x4 v0 = acc[ai][bj][m][0], v1 = acc[ai][bj][m][1];
                        if (act) {
#pragma unroll
                            for (int i = 0; i < 4; ++i) { v0[i] = silu_f(v0[i]); v1[i] = silu_f(v1[i]); }
                        }
                        u32x4 a; a.x = cvtpk(v0[0], v0[1]); a.y = cvtpk(v0[2], v0[3]); a.z = cvtpk(v1[0], v1[1]); a.w = cvtpk(v1[2], v1[3]);
                        *(u32x4*)(rowp + bj * 32) = a;
                    }
                }
        }
    }
};
struct EpiOut {
    static constexpr bool PERM = true, AFTER_DRAIN = false, INIT = true;
    const float* x; float* out;
    __device__ __forceinline__ void init(f32x4 (&acc)[2][2][4][2], const pg8::Unit& u, int wr, int wc, int fr, int fq) const {
        const int row0 = u.pm * 256 + wr * 64 + fr, col0 = u.pn * 256 + wc * 32 + fq * 8;
#pragma unroll
        for (int ai = 0; ai < 2; ++ai)
#pragma unroll
            for (int m = 0; m < 4; ++m) { const size_t off = (size_t)(row0 + ai * 128 + m * 16) * DM + col0;
#pragma unroll
                for (int bj = 0; bj < 2; ++bj) { acc[ai][bj][m][0] = __builtin_nontemporal_load((const f32x4*)(x + off + bj * 128)); acc[ai][bj][m][1] = __builtin_nontemporal_load((const f32x4*)(x + off + bj * 128 + 4)); } }
    }
    __device__ __forceinline__ void operator()(const f32x4 (&acc)[2][2][4][2], const pg8::Unit& u, int wr, int wc, int fr, int fq) const {
        const int row0 = u.pm * 256 + wr * 64 + fr, col0 = u.pn * 256 + wc * 32 + fq * 8;
#pragma unroll
        for (int ai = 0; ai < 2; ++ai)
#pragma unroll
            for (int m = 0; m < 4; ++m) { const size_t off = (size_t)(row0 + ai * 128 + m * 16) * DM + col0;
#pragma unroll
                for (int bj = 0; bj < 2; ++bj) { *(f32x4*)(out + off + bj * 128) = acc[ai][bj][m][0]; *(f32x4*)(out + off + bj * 128 + 4) = acc[ai][bj][m][1]; } }
    }
};

namespace att {
constexpr int KVBLK = 64, NT = SEQ / KVBLK, LD = 128;
constexpr int SHM_V = KVBLK * 128 * 2, SHM_K = KVBLK * 128 * 2;
constexpr int OFF_V = 0, OFF_K = 2 * SHM_V, OFF_WS = 2 * SHM_V + 2 * SHM_K;
#define KSWZ(row, colB) ((row) * 256 + ((colB) ^ (((row) & 7) << 4)))
#define SBAR() __builtin_amdgcn_sched_barrier(0)
__device__ __forceinline__ int crow(int r, int hi) { return (r & 3) + 8 * (r >> 2) + 4 * hi; }
__device__ __forceinline__ int v_st(int k, int c) { const int kk = (k & ~0xC) | ((k & 4) << 1) | ((k & 8) >> 1); return ((kk >> 3) * 4 + (c >> 5)) * 512 + ((kk & 7) * 32 + (c & 31)) * 2; }
__device__ __forceinline__ int v_rd_base(int lane) { return ((lane & 3) << 3) | (((lane >> 2) & 3) << 6) | (((lane >> 4) & 1) << 5) | (((lane >> 5) & 1) << 8); }
constexpr int v_rd_off(int d0, int ks, int half) { return d0 * 512 + ks * 4096 + half * 2048; }
template <int OFF> __device__ __forceinline__ s16x4 tr_read(int vb) {
    s16x4 r; asm volatile("ds_read_b64_tr_b16 %0, %1 offset:%2" : "=&v"(r) : "v"(vb), "i"(OFF) : "memory"); return r;
}
template <int D0> __device__ __forceinline__ void pv_one(f32x16& od, int vb, bf16x8 pa0, bf16x8 pa1, bf16x8 pa2, bf16x8 pa3) {
    const s16x4 l0 = tr_read<v_rd_off(D0, 0, 0)>(vb), h0 = tr_read<v_rd_off(D0, 0, 1)>(vb), l1 = tr_read<v_rd_off(D0, 1, 0)>(vb), h1 = tr_read<v_rd_off(D0, 1, 1)>(vb);
    const s16x4 l2 = tr_read<v_rd_off(D0, 2, 0)>(vb), h2 = tr_read<v_rd_off(D0, 2, 1)>(vb), l3 = tr_read<v_rd_off(D0, 3, 0)>(vb), h3 = tr_read<v_rd_off(D0, 3, 1)>(vb);
    asm volatile("s_waitcnt lgkmcnt(0)" ::: "memory"); SBAR();
#define PK(L, H) (bf16x8){L[0], L[1], L[2], L[3], H[0], H[1], H[2], H[3]}
    od = __builtin_amdgcn_mfma_f32_32x32x16_bf16(pa0, PK(l0, h0), od, 0, 0, 0);
    od = __builtin_amdgcn_mfma_f32_32x32x16_bf16(pa1, PK(l1, h1), od, 0, 0, 0);
    od = __builtin_amdgcn_mfma_f32_32x32x16_bf16(pa2, PK(l2, h2), od, 0, 0, 0);
    od = __builtin_amdgcn_mfma_f32_32x32x16_bf16(pa3, PK(l3, h3), od, 0, 0, 0);
#undef PK
}
__device__ __forceinline__ void pv_d0(f32x16* o, int vb, bf16x8 pa0, bf16x8 pa1, bf16x8 pa2, bf16x8 pa3) {
    pv_one<0>(o[0], vb, pa0, pa1, pa2, pa3); pv_one<1>(o[1], vb, pa0, pa1, pa2, pa3); pv_one<2>(o[2], vb, pa0, pa1, pa2, pa3); pv_one<3>(o[3], vb, pa0, pa1, pa2, pa3);
}
__device__ __forceinline__ void qkt(f32x16& p0, f32x16& p1, const char* Ks, const bf16x8* qr, int comp, int r32, int hi) {
    const f32x16 zero = f32x16{};
#pragma unroll
    for (int d = 0; d < 4; ++d) { const int cb = ((comp * 4 + d) * 16 + hi * 8) * 2;
        const bf16x8 b0 = *reinterpret_cast<const bf16x8*>(Ks + KSWZ(r32, cb));
        const bf16x8 b1 = *reinterpret_cast<const bf16x8*>(Ks + KSWZ(32 + r32, cb));
        if (d == 0) { p0 = __builtin_amdgcn_mfma_f32_32x32x16_bf16(b0, qr[0], zero, 0, 0, 0); p1 = __builtin_amdgcn_mfma_f32_32x32x16_bf16(b1, qr[0], zero, 0, 0, 0); }
        else { p0 = __builtin_amdgcn_mfma_f32_32x32x16_bf16(b0, qr[d], p0, 0, 0, 0); p1 = __builtin_amdgcn_mfma_f32_32x32x16_bf16(b1, qr[d], p1, 0, 0, 0); } }
}
template <bool SHIFT> __device__ __forceinline__ void partialSM(f32x16& p0, float negM2) {
#pragma unroll
    for (int r = 0; r < 16; ++r) p0[r] = __builtin_amdgcn_exp2f(SHIFT ? p0[r] + negM2 : p0[r]);
}
template <bool SHIFT> __device__ __forceinline__ void finishSM(f32x16& p0, f32x16& p1, float negM2, float& l_reg, bf16x8& pa0, bf16x8& pa1, bf16x8& pa2, bf16x8& pa3) {
#pragma unroll
    for (int r = 0; r < 16; ++r) p1[r] = __builtin_amdgcn_exp2f(SHIFT ? p1[r] + negM2 : p1[r]);
    float ps = 0.f;
#pragma unroll
    for (int r = 0; r < 16; ++r) ps += p0[r];
#pragma unroll
    for (int r = 0; r < 16; ++r) ps += p1[r];
    l_reg += ps;
#define PK4(P, BASE, OUT) do { unsigned a0 = cvtpk(P[BASE + 0], P[BASE + 1]), a1 = cvtpk(P[BASE + 2], P[BASE + 3]);   \
    unsigned b0 = cvtpk(P[BASE + 4], P[BASE + 5]), b1 = cvtpk(P[BASE + 6], P[BASE + 7]);                              \
    auto r0 = __builtin_amdgcn_permlane32_swap(a0, b0, false, false); auto r1 = __builtin_amdgcn_permlane32_swap(a1, b1, false, false); \
    u32x4 w = {r0[0], r1[0], r0[1], r1[1]}; OUT = *reinterpret_cast<bf16x8*>(&w); } while (0)
    PK4(p0, 0, pa0); PK4(p0, 8, pa1); PK4(p1, 0, pa2); PK4(p1, 8, pa3);
#undef PK4
}

struct Tensors { const bf16_t *Q, *K, *V, *GA; bf16_t* MIX; const float* subw; float lam, negM2; };
__device__ __forceinline__ void epilogue(f32x16 (&o)[4], float l_reg, int b, int h, int qb, const Tensors& T, char* lds);

template <bool SHIFT> __device__ __forceinline__ void unit(int b, int h, int qb, const Tensors& T, char* lds) {
    const float negM2 = T.negM2;
    int tid = threadIdx.x; asm volatile("" : "+v"(tid));
    const int wid = __builtin_amdgcn_readfirstlane(tid >> 6), lane = tid & 63, r32 = lane & 31, hi = lane >> 5;
    const int comp = wid >> 2, rw = wid & 3;
    char* V_lds = lds + OFF_V; char* K_lds = lds + OFF_K;
    float* wsf = (float*)(lds + OFF_WS) + wid * 64;
    const long rowbase = (long)b * SEQ; const int q0 = qb * 128;
    const long hb = (long)(b * NH + h) * SEQ;
    const bf16_t* Kh = T.K + hb * LD; const bf16_t* Vh = T.V + hb * LD;
    bf16x8 qr[4];
    { const bf16_t* Qw = T.Q + (hb + q0 + rw * 32 + r32) * LD + comp * 64 + hi * 8;
#pragma unroll
      for (int d = 0; d < 4; ++d) qr[d] = *reinterpret_cast<const bf16x8*>(Qw + d * 16); }
    float l_reg = 0.f; f32x16 o[4];
#pragma unroll
    for (int d = 0; d < 4; ++d) o[d] = f32x16{};
    const int sr = tid >> 4, sc = (tid & 15) * 8, vst0 = v_st(sr, sc), vst1 = v_st(32 + sr, sc);
    const int vb0 = (int)(uintptr_t)V_lds + v_rd_base(lane);
    struct { bf16x8 vs0, vs1, ks0, ks1; } sr_[2];
#define LD8(p) (*reinterpret_cast<const bf16x8*>(p))
#define SLOAD(i, k0) do { sr_[i].vs0 = LD8(&Vh[(long)((k0) + sr) * LD + sc]); sr_[i].vs1 = LD8(&Vh[(long)((k0) + 32 + sr) * LD + sc]); \
    sr_[i].ks0 = LD8(&Kh[(long)((k0) + sr) * LD + sc]); sr_[i].ks1 = LD8(&Kh[(long)((k0) + 32 + sr) * LD + sc]); } while (0)
#define SWRITE(bb, i) do { *(bf16x8*)(V_lds + (bb) * SHM_V + vst0) = sr_[i].vs0;          \
    *(bf16x8*)(V_lds + (bb) * SHM_V + vst1) = sr_[i].vs1; const int kc = sc * 2;               \
    *(bf16x8*)(K_lds + (bb) * SHM_K + KSWZ(sr, kc)) = sr_[i].ks0;                       \
    *(bf16x8*)(K_lds + (bb) * SHM_K + KSWZ(32 + sr, kc)) = sr_[i].ks1; } while (0)
#define SWAIT() asm volatile("s_waitcnt vmcnt(4)" ::: "memory")
    f32x16 pA0, pA1, pB0, pB1; bf16x8 pa0, pa1, pa2, pa3;
    constexpr int SE = 0, SO = 1;
    SLOAD(SE, 0); asm volatile("s_waitcnt vmcnt(0)" ::: "memory"); SWRITE(0, SE); __syncthreads();
    qkt(pA0, pA1, K_lds, qr, comp, r32, hi); partialSM<SHIFT>(pA0, negM2);
    SLOAD(SO, KVBLK); SLOAD(SE, 2 * KVBLK);
    SWAIT(); SWRITE(1, SO); __syncthreads();
#pragma unroll 1
    for (int j = 1; j + 1 < NT; j += 2) {
        SBAR(); qkt(pB0, pB1, K_lds + SHM_K, qr, comp, r32, hi);
        finishSM<SHIFT>(pA0, pA1, negM2, l_reg, pa0, pa1, pa2, pa3); SBAR();
        SLOAD(SO, (j + 2) * KVBLK); SBAR();
        pv_d0(o, vb0, pa0, pa1, pa2, pa3); partialSM<SHIFT>(pB0, negM2);
        __syncthreads(); SWAIT(); SWRITE(0, SE);
        __syncthreads();
        SBAR(); qkt(pA0, pA1, K_lds, qr, comp, r32, hi);
        finishSM<SHIFT>(pB0, pB1, negM2, l_reg, pa0, pa1, pa2, pa3); SBAR();
        SLOAD(SE, (j + 3 < NT ? j + 3 : NT - 1) * KVBLK); SBAR();
        pv_d0(o, vb0 + SHM_V, pa0, pa1, pa2, pa3); partialSM<SHIFT>(pA0, negM2);
        __syncthreads(); SWAIT(); SWRITE(1, SO);
        __syncthreads();
    }
    SBAR(); qkt(pB0, pB1, K_lds + SHM_K, qr, comp, r32, hi);
    finishSM<SHIFT>(pA0, pA1, negM2, l_reg, pa0, pa1, pa2, pa3); SBAR();
    pv_d0(o, vb0, pa0, pa1, pa2, pa3); partialSM<SHIFT>(pB0, negM2);
    finishSM<SHIFT>(pB0, pB1, negM2, l_reg, pa0, pa1, pa2, pa3); SBAR();
    pv_d0(o, vb0 + SHM_V, pa0, pa1, pa2, pa3);
#undef SLOAD
#undef SWRITE
#undef SWAIT
#undef LD8
    epilogue(o, l_reg, b, h, qb, T, lds);
}
__device__ __forceinline__ void epilogue(f32x16 (&o)[4], float l_reg, int b, int h, int qb, const Tensors& T, char* lds) {
    int tid = threadIdx.x; asm volatile("" : "+v"(tid));
    const int wid = __builtin_amdgcn_readfirstlane(tid >> 6), lane = tid & 63, r32 = lane & 31, hi = lane >> 5;
    const int comp = wid >> 2, rw = wid & 3;
    float* wsf = (float*)(lds + OFF_WS) + wid * 64;
    const long rowbase = (long)b * SEQ; const int q0 = qb * 128;
    { auto rr = __builtin_amdgcn_permlane32_swap(__float_as_uint(l_reg), __float_as_uint(l_reg), false, false); l_reg = __uint_as_float(rr[0]) + __uint_as_float(rr[1]); }
    if (hi == 0) wsf[r32] = l_reg;
    asm volatile("s_waitcnt lgkmcnt(0)" ::: "memory");
    float rli[16];
#pragma unroll
    for (int r = 0; r < 16; ++r) rli[r] = __builtin_amdgcn_rcpf(wsf[crow(r, hi)]);
    __syncthreads();
    float* X = (float*)lds + rw * 4096;
    if (comp == 1) {
        const float lam = T.lam;
#pragma unroll
        for (int r = 0; r < 16; ++r) { const float f = rli[r] * lam;
#pragma unroll
            for (int d = 0; d < 4; ++d) X[crow(r, hi) * 128 + d * 32 + r32] = o[d][r] * f; }
    }
    __syncthreads();
    if (comp == 0) {
        float sw[4];
#pragma unroll
        for (int d = 0; d < 4; ++d) sw[d] = T.subw[d * 32 + r32] * (1.0f - LAM_INIT);
#pragma unroll
        for (int r = 0; r < 16; ++r) {
            float a[4]; float ss = 0.f;
#pragma unroll
            for (int d = 0; d < 4; ++d) { a[d] = o[d][r] * rli[r] - X[crow(r, hi) * 128 + d * 32 + r32]; ss += a[d] * a[d]; }
            ss += __shfl_xor(ss, 1); ss += __shfl_xor(ss, 2); ss += __shfl_xor(ss, 4); ss += __shfl_xor(ss, 8); ss += __shfl_xor(ss, 16);
            const float rs = 1.0f / sqrtf(ss * (1.0f / 128.0f) + EPSN);
#pragma unroll
            for (int d = 0; d < 4; ++d) X[crow(r, hi) * 128 + d * 32 + r32] = a[d] * rs * sw[d];
        }
    }
    __syncthreads();
#pragma unroll
    for (int i = 0; i < 4; ++i) {
        const int idx = i * 64 + lane, row = comp * 16 + (idx >> 4), ch = idx & 15;
        const f32x4 z0 = *(const f32x4*)(X + row * 128 + ch * 8), z1 = *(const f32x4*)(X + row * 128 + ch * 8 + 4);
        const long grow = rowbase + q0 + rw * 32 + row;
        const u32x4 g = *(const u32x4*)(T.GA + grow * AW + h * 128 + ch * 8);
        u32x4 w;
        w.x = cvtpk(z0[0] * bf_lo(g.x), z0[1] * bf_hi(g.x)); w.y = cvtpk(z0[2] * bf_lo(g.y), z0[3] * bf_hi(g.y));
        w.z = cvtpk(z1[0] * bf_lo(g.z), z1[1] * bf_hi(g.z)); w.w = cvtpk(z1[2] * bf_lo(g.w), z1[3] * bf_hi(g.w));
        *(u32x4*)(T.MIX + grow * DM + h * 128 + ch * 8) = w;
    }
    __syncthreads();
}
}


namespace att2 {
#ifndef DEBUG_SYNC_COPY
#define DEBUG_SYNC_COPY 0
#endif
using att::crow; using att::Tensors; using att::tr_read; using att::v_rd_off; using att::v_rd_base;
constexpr int NT = SEQ / 64, SHM = 16384;
constexpr int OFF_Q = 0, OFF_V = 65536, OFF_K = 98304, OFF_WS = 131072;
typedef LAS unsigned char* ldsp;
__device__ __forceinline__ void glds16s(unsigned voff, const void* sbase, unsigned lds_dst) { unsigned keep;
    asm volatile("s_mov_b32 %0, m0\n\ts_mov_b32 m0, %3\n\ts_nop 0\n\tglobal_load_lds_dwordx4 %1, %2\n\ts_mov_b32 m0, %0" : "=&s"(keep) : "v"(voff), "s"(sbase), "s"(lds_dst) : "memory"); }
typedef __bf16 bf16x2_t __attribute__((ext_vector_type(2)));
__device__ __forceinline__ unsigned cvtpk_s(float lo, float hi) { f32x2 v = {lo, hi}; bf16x2_t b = __builtin_convertvector(v, bf16x2_t); return __builtin_bit_cast(unsigned, b); }
template <int H, int D0> __device__ __forceinline__ void v_rd4(s16x4 (&f)[4], int vb) {
    f[0] = tr_read<v_rd_off(D0, 2 * H, 0)>(vb); f[1] = tr_read<v_rd_off(D0, 2 * H, 1)>(vb); f[2] = tr_read<v_rd_off(D0, 2 * H + 1, 0)>(vb); f[3] = tr_read<v_rd_off(D0, 2 * H + 1, 1)>(vb);
}
__device__ __forceinline__ void pv_mma(f32x16& oa, f32x16& ob, const s16x4 (&f)[4], const bf16x8 (&pa)[2], const bf16x8 (&pb)[2]) {
#define PK(L, H_) (bf16x8){L[0], L[1], L[2], L[3], H_[0], H_[1], H_[2], H_[3]}
    const bf16x8 v0 = PK(f[0], f[1]), v1 = PK(f[2], f[3]);
#undef PK
    oa = __builtin_amdgcn_mfma_f32_32x32x16_bf16(pa[0], v0, oa, 0, 0, 0);
    ob = __builtin_amdgcn_mfma_f32_32x32x16_bf16(pb[0], v0, ob, 0, 0, 0);
    oa = __builtin_amdgcn_mfma_f32_32x32x16_bf16(pa[1], v1, oa, 0, 0, 0);
    ob = __builtin_amdgcn_mfma_f32_32x32x16_bf16(pb[1], v1, ob, 0, 0, 0);
}
template <int H> __device__ __forceinline__ void pv_half(f32x16 (&o0)[4], f32x16 (&o1)[4], int vb, const bf16x8 (&pa)[2], const bf16x8 (&pb)[2]) {
    s16x4 fa[4], fb[4];
    SBAR();
    v_rd4<H, 0>(fa, vb); v_rd4<H, 1>(fb, vb);
    asm volatile("s_waitcnt lgkmcnt(4)" ::: "memory"); SBAR();
    pv_mma(o0[0], o1[0], fa, pa, pb); SBAR();
    v_rd4<H, 2>(fa, vb);
    asm volatile("s_waitcnt lgkmcnt(4)" ::: "memory"); SBAR();
    pv_mma(o0[1], o1[1], fb, pa, pb); SBAR();
    v_rd4<H, 3>(fb, vb);
    asm volatile("s_waitcnt lgkmcnt(4)" ::: "memory"); SBAR();
    pv_mma(o0[2], o1[2], fa, pa, pb); SBAR();
    asm volatile("s_waitcnt lgkmcnt(0)" ::: "memory"); SBAR();
    pv_mma(o0[3], o1[3], fb, pa, pb); SBAR();
}
template <int C, int H> __device__ __forceinline__ void qkt_half(f32x16& p, ldsp Kb, ldsp Qw, const int (&fa)[4]) {
    const f32x16 zero = f32x16{};
#pragma unroll
    for (int d = 0; d < 4; ++d) {
        const bf16x8 q = *(const LAS bf16x8*)(Qw + fa[d] + C * 128);
        const bf16x8 kf = *(const LAS bf16x8*)(Kb + fa[d] + C * 128 + H * 8192);
        if (d == 0) p = __builtin_amdgcn_mfma_f32_32x32x16_bf16(kf, q, zero, 0, 0, 0);
        else p = __builtin_amdgcn_mfma_f32_32x32x16_bf16(kf, q, p, 0, 0, 0); }
}
template <int C, int H> __device__ __forceinline__ void qkt_half_r(f32x16& p, ldsp Kb, const bf16x8 (&qa)[4], const int (&fa)[4]) {
    const f32x16 zero = f32x16{};
#pragma unroll
    for (int d = 0; d < 4; ++d) {
        const bf16x8 kf = *(const LAS bf16x8*)(Kb + fa[d] + C * 128 + H * 8192);
        if (d == 0) p = __builtin_amdgcn_mfma_f32_32x32x16_bf16(kf, qa[0], zero, 0, 0, 0);
        else p = __builtin_amdgcn_mfma_f32_32x32x16_bf16(kf, qa[d], p, 0, 0, 0); }
}
template <bool SHIFT> __device__ __forceinline__ void softmax_half(f32x16& p, float negM2, float& l_reg, bf16x8 (&pa)[2]) {
#pragma unroll
    for (int r = 0; r < 16; ++r) p[r] = __builtin_amdgcn_exp2f(SHIFT ? p[r] + negM2 : p[r]);
#pragma unroll
    for (int r = 0; r < 16; ++r) l_reg += p[r];
#define PK4(P, BASE, OUT) do { unsigned a0 = cvtpk_s(P[BASE + 0], P[BASE + 1]), a1 = cvtpk_s(P[BASE + 2], P[BASE + 3]);   \
    unsigned b0 = cvtpk_s(P[BASE + 4], P[BASE + 5]), b1 = cvtpk_s(P[BASE + 6], P[BASE + 7]);                              \
    auto r0 = __builtin_amdgcn_permlane32_swap(a0, b0, false, false); auto r1 = __builtin_amdgcn_permlane32_swap(a1, b1, false, false); \
    u32x4 w = {r0[0], r1[0], r0[1], r1[1]}; OUT = *reinterpret_cast<bf16x8*>(&w); } while (0)
    PK4(p, 0, pa[0]); PK4(p, 8, pa[1]);
#undef PK4
}
template <bool SHIFT, int H, class Mid> __device__ __forceinline__ void half_tile(ldsp Kb, int vb, ldsp Qw, const int (&fa)[4], const bf16x8 (&qa)[4], const bf16x8 (&qb_)[4], float negM2, f32x16 (&o0)[4], f32x16 (&o1)[4], float& l0, float& l1, Mid&& mid) {
    f32x16 sa, sb; bf16x8 pa[2], pb[2];
    asm volatile("" : "+v"(l0) : "v"(l1));
    qkt_half_r<0, H>(sa, Kb, qa, fa);
    qkt_half_r<1, H>(sb, Kb, qb_, fa);
    if (H == 1) {
#pragma unroll
        for (int i = 0; i < 8; ++i) { __builtin_amdgcn_sched_group_barrier(0x008, 1, 0); __builtin_amdgcn_sched_group_barrier(0x100, 2, 0); }
    }
    softmax_half<SHIFT>(sa, negM2, l0, pa);
    asm volatile("" : "+v"(l1) : "v"(l0));
    SBAR();
    s16x4 f0[4], f1[4], f2[4], f3[4];
    v_rd4<H, 0>(f0, vb); v_rd4<H, 1>(f1, vb); v_rd4<H, 2>(f2, vb); v_rd4<H, 3>(f3, vb);
    asm volatile("s_waitcnt lgkmcnt(0)" ::: "memory"); SBAR();
    mid();
    SBAR();
#define PK(L, H_) (bf16x8){L[0], L[1], L[2], L[3], H_[0], H_[1], H_[2], H_[3]}
    const bf16x8 v00 = PK(f0[0], f0[1]), v01 = PK(f0[2], f0[3]), v10 = PK(f1[0], f1[1]), v11 = PK(f1[2], f1[3]);
    const bf16x8 v20 = PK(f2[0], f2[1]), v21 = PK(f2[2], f2[3]), v30 = PK(f3[0], f3[1]), v31 = PK(f3[2], f3[3]);
#undef PK
    o0[0] = __builtin_amdgcn_mfma_f32_32x32x16_bf16(pa[0], v00, o0[0], 0, 0, 0);
    o0[1] = __builtin_amdgcn_mfma_f32_32x32x16_bf16(pa[0], v10, o0[1], 0, 0, 0);
    o0[2] = __builtin_amdgcn_mfma_f32_32x32x16_bf16(pa[0], v20, o0[2], 0, 0, 0);
    o0[3] = __builtin_amdgcn_mfma_f32_32x32x16_bf16(pa[0], v30, o0[3], 0, 0, 0);
    o0[0] = __builtin_amdgcn_mfma_f32_32x32x16_bf16(pa[1], v01, o0[0], 0, 0, 0);
    o0[1] = __builtin_amdgcn_mfma_f32_32x32x16_bf16(pa[1], v11, o0[1], 0, 0, 0);
    o0[2] = __builtin_amdgcn_mfma_f32_32x32x16_bf16(pa[1], v21, o0[2], 0, 0, 0);
    o0[3] = __builtin_amdgcn_mfma_f32_32x32x16_bf16(pa[1], v31, o0[3], 0, 0, 0);
    softmax_half<SHIFT>(sb, negM2, l1, pb);
#pragma unroll
    for (int i = 0; i < 8; ++i) { __builtin_amdgcn_sched_group_barrier(0x008, 1, 0); __builtin_amdgcn_sched_group_barrier(0x402, 6, 0); }
    o1[0] = __builtin_amdgcn_mfma_f32_32x32x16_bf16(pb[0], v00, o1[0], 0, 0, 0);
    o1[1] = __builtin_amdgcn_mfma_f32_32x32x16_bf16(pb[0], v10, o1[1], 0, 0, 0);
    o1[2] = __builtin_amdgcn_mfma_f32_32x32x16_bf16(pb[0], v20, o1[2], 0, 0, 0);
    o1[3] = __builtin_amdgcn_mfma_f32_32x32x16_bf16(pb[0], v30, o1[3], 0, 0, 0);
    o1[0] = __builtin_amdgcn_mfma_f32_32x32x16_bf16(pb[1], v01, o1[0], 0, 0, 0);
    o1[1] = __builtin_amdgcn_mfma_f32_32x32x16_bf16(pb[1], v11, o1[1], 0, 0, 0);
    o1[2] = __builtin_amdgcn_mfma_f32_32x32x16_bf16(pb[1], v21, o1[2], 0, 0, 0);
    o1[3] = __builtin_amdgcn_mfma_f32_32x32x16_bf16(pb[1], v31, o1[3], 0, 0, 0);
}
template <bool SHIFT, class Mid> __device__ __forceinline__ void tile(ldsp Kb, int vb, ldsp Qw, const int (&fa)[4], const bf16x8 (&qa)[4], const bf16x8 (&qb_)[4], float negM2, f32x16 (&o0)[4], f32x16 (&o1)[4], float& l0, float& l1, Mid&& mid) {
    half_tile<SHIFT, 0>(Kb, vb, Qw, fa, qa, qb_, negM2, o0, o1, l0, l1, [] {});
    half_tile<SHIFT, 1>(Kb, vb, Qw, fa, qa, qb_, negM2, o0, o1, l0, l1, mid);
}
__device__ __forceinline__ void epilogue2(f32x16 (&o0)[4], f32x16 (&o1)[4], float l0, float l1, int b, int h, int qb, const Tensors& T, char* lds);

template <bool SHIFT> __device__ __forceinline__ void unit(int b, int h, int qb, const Tensors& T, char* ldsc) {
    int tid = threadIdx.x; asm volatile("" : "+v"(tid));
    const int wid = __builtin_amdgcn_readfirstlane(tid >> 6), lane = tid & 63, r32 = lane & 31, hi = lane >> 5;
    ldsp lds = (ldsp)ldsc;
    const long hb = (long)(b * NH + h) * SEQ;
    const bf16_t* Kh = T.K + hb * 128; const bf16_t* Vh = T.V + hb * 128;
    const unsigned lds0 = (unsigned)(uintptr_t)ldsc;
    const unsigned kdst = lds0 + OFF_K + wid * 2048, vdst = lds0 + OFF_V + wid * 2048;
    unsigned dko[2], dvo[2];
#pragma unroll
    for (int i_ = 0; i_ < 2; ++i_) { const int c_ = wid * 2 + i_;
        const int row_ = 4 * c_ + (lane >> 4), pc_ = lane & 15; dko[i_] = (unsigned)(row_ * 128 + ((pc_ ^ (row_ & 7)) * 8)) * 2u;
        const int s_ = 2 * c_ + (lane >> 5), kk_ = (s_ >> 2) * 8 + ((lane & 31) >> 2), col_ = (s_ & 3) * 32 + (lane & 3) * 8;
        const int k_ = (kk_ & ~0xC) | ((kk_ & 4) << 1) | ((kk_ & 8) >> 1); dvo[i_] = (unsigned)(k_ * 128 + col_) * 2u; }
#define DMA_TILE(t, buf) do { const char* kt_ = (const char*)Kh + (size_t)(t) * 16384; const char* vt_ = (const char*)Vh + (size_t)(t) * 16384; \
        glds16s(dko[0], kt_, kdst + (buf) * SHM); glds16s(dvo[0], vt_, vdst + (buf) * SHM); \
        glds16s(dko[1], kt_, kdst + (buf) * SHM + 1024); glds16s(dvo[1], vt_, vdst + (buf) * SHM + 1024); } while (0)
    DMA_TILE(0, 0);
    ldsp Qw = lds + OFF_Q + wid * 8192;
    { const bf16_t* Qg = T.Q + (hb + qb * 256 + wid * 32) * 128;
      bf16x8 qv[8];
#pragma unroll
      for (int i = 0; i < 8; ++i) qv[i] = __builtin_nontemporal_load(reinterpret_cast<const bf16x8*>(Qg + (i * 4 + (lane >> 4)) * 128 + (lane & 15) * 8));
#pragma unroll
      for (int i = 0; i < 8; ++i) { const int row = i * 4 + (lane >> 4); *(LAS bf16x8*)(Qw + row * 256 + (((lane & 15) * 16) ^ ((row & 7) << 4))) = qv[i]; } }
    const float negM2 = T.negM2;
    float l0 = 0.f, l1 = 0.f; f32x16 o0[4], o1[4];
#pragma unroll
    for (int d = 0; d < 4; ++d) { o0[d] = f32x16{}; o1[d] = f32x16{}; }
    const int vb0 = (int)(uintptr_t)(lds + OFF_V) + v_rd_base(lane);
    int fa[4];
#pragma unroll
    for (int d = 0; d < 4; ++d) fa[d] = r32 * 256 + ((d * 32 + hi * 16) ^ ((r32 & 7) << 4));
#define OPEN_TILE() do { asm volatile("s_waitcnt vmcnt(0) lgkmcnt(0)" ::: "memory"); __builtin_amdgcn_s_barrier(); asm volatile("" ::: "memory"); } while (0)
    OPEN_TILE(); DMA_TILE(1, 1);
    if (wid >= 4) __builtin_amdgcn_s_setprio(1);
    bf16x8 qa[4], qb_[4];
#pragma unroll
    for (int d = 0; d < 4; ++d) { qa[d] = *(const LAS bf16x8*)(Qw + fa[d]); qb_[d] = *(const LAS bf16x8*)(Qw + fa[d] + 128); }
#pragma unroll 1
    for (int t = 0; t < NT; t += 2) {
        tile<SHIFT>(lds + OFF_K, vb0, Qw, fa, qa, qb_, negM2, o0, o1, l0, l1, [&] { OPEN_TILE(); DMA_TILE((t + 2 < NT ? t + 2 : NT - 1), 0); });
        tile<SHIFT>(lds + OFF_K + SHM, vb0 + SHM, Qw, fa, qa, qb_, negM2, o0, o1, l0, l1, [&] { OPEN_TILE(); DMA_TILE((t + 3 < NT ? t + 3 : NT - 1), 1); });
    }
#undef DMA_TILE
#undef OPEN_TILE
    __builtin_amdgcn_s_setprio(0);
    asm volatile("s_waitcnt vmcnt(0) lgkmcnt(0)" ::: "memory"); __builtin_amdgcn_s_barrier(); asm volatile("" ::: "memory");
    epilogue2(o0, o1, l0, l1, b, h, qb, T, ldsc);
}
__device__ __forceinline__ void epilogue2(f32x16 (&o0)[4], f32x16 (&o1)[4], float l0, float l1, int b, int h, int qb, const Tensors& T, char* lds) {
    int tid = threadIdx.x; asm volatile("" : "+v"(tid));
    const int wid = __builtin_amdgcn_readfirstlane(tid >> 6), lane = tid & 63, r32 = lane & 31, hi = lane >> 5;
    float* wsf = (float*)(lds + OFF_WS) + wid * 64;
    { auto rr = __builtin_amdgcn_permlane32_swap(__float_as_uint(l0), __float_as_uint(l0), false, false); l0 = __uint_as_float(rr[0]) + __uint_as_float(rr[1]); }
    { auto rr = __builtin_amdgcn_permlane32_swap(__float_as_uint(l1), __float_as_uint(l1), false, false); l1 = __uint_as_float(rr[0]) + __uint_as_float(rr[1]); }
    if (hi == 0) { wsf[r32] = l0; wsf[32 + r32] = l1; }
    asm volatile("s_waitcnt lgkmcnt(0)" ::: "memory");
    float* X = (float*)(lds + wid * 16384);
    float sw[4];
#pragma unroll
    for (int d = 0; d < 4; ++d) sw[d] = T.subw[d * 32 + r32] * (1.0f - LAM_INIT);
    const float lam = T.lam;
#pragma unroll
    for (int r = 0; r < 16; ++r) {
        const int row = crow(r, hi);
        const float f1 = lam * __builtin_amdgcn_rcpf(wsf[32 + row]);
#pragma unroll
        for (int d = 0; d < 4; ++d) X[row * 128 + d * 32 + r32] = o1[d][r] * f1;
    }
    asm volatile("s_waitcnt lgkmcnt(0)" ::: "memory"); SBAR();
#pragma unroll
    for (int r = 0; r < 16; ++r) {
        const int row = crow(r, hi);
        const float f0 = __builtin_amdgcn_rcpf(wsf[row]);
        float a[4]; float ss = 0.f;
#pragma unroll
        for (int d = 0; d < 4; ++d) { a[d] = o0[d][r] * f0 - X[row * 128 + d * 32 + r32]; ss += a[d] * a[d]; }
        ss += __shfl_xor(ss, 1); ss += __shfl_xor(ss, 2); ss += __shfl_xor(ss, 4); ss += __shfl_xor(ss, 8); ss += __shfl_xor(ss, 16);
        const float rs = 1.0f / sqrtf(ss * (1.0f / 128.0f) + EPSN);
#pragma unroll
        for (int d = 0; d < 4; ++d) X[row * 128 + d * 32 + r32] = a[d] * rs * sw[d];
        SBAR();
    }
    asm volatile("s_waitcnt lgkmcnt(0)" ::: "memory");
    const long grow0 = (long)b * SEQ + qb * 256 + wid * 32;
#pragma unroll
    for (int i = 0; i < 8; ++i) {
        const int idx = i * 64 + lane, row = idx >> 4, ch = idx & 15;
        const f32x4 z0 = *(const f32x4*)(X + row * 128 + ch * 8), z1 = *(const f32x4*)(X + row * 128 + ch * 8 + 4);
        const u32x4 g = __builtin_nontemporal_load((const u32x4*)(T.GA + (grow0 + row) * AW + h * 128 + ch * 8));
        u32x4 w;
        w.x = cvtpk(z0[0] * bf_lo(g.x), z0[1] * bf_hi(g.x)); w.y = cvtpk(z0[2] * bf_lo(g.y), z0[3] * bf_hi(g.y));
        w.z = cvtpk(z1[0] * bf_lo(g.z), z1[1] * bf_hi(g.z)); w.w = cvtpk(z1[2] * bf_lo(g.w), z1[3] * bf_hi(g.w));
        *(u32x4*)(T.MIX + (grow0 + row) * LDP + h * 128 + ch * 8) = w;
    }
    __syncthreads();
}
}

template <int LO> __device__ __forceinline__ void pool_dg(const unsigned (&raw)[47], bf16_t* dst, int p0) {
    constexpr int HI = LO - 1, DGS = 1032;
    float sx = 0.f, sy = 0.f;
#pragma unroll
    for (int j = 8 - LO; j <= 8 + HI; ++j) { sx += bf_lo(raw[j]); sy += bf_hi(raw[j]); }
#pragma unroll
    for (int i = 0; i < 32; ++i) {
        const int p = p0 + i;
        const int cnt = min(p + HI, SEQ - 1) - max(p - LO, 0) + 1;
        const float rc = 1.0f / (float)cnt;
        *(unsigned*)(dst + i * DGS) = cvtpk(sx * rc - bf_lo(raw[i + 8]), sy * rc - bf_hi(raw[i + 8]));
        if (i < 31) { sx += bf_lo(raw[i + 8 + HI + 1]) - bf_lo(raw[i + 8 - LO]); sy += bf_hi(raw[i + 8 + HI + 1]) - bf_hi(raw[i + 8 - LO]); }
    }
}
__device__ __forceinline__ void pool_job(int blk, const bf16_t* U, const bf16_t* GP, const bf16_t* WPT, const float* pscale, bf16_t* MIX, char* lds) {
    int tid = threadIdx.x; asm volatile("" : "+v"(tid));
    const int wid = __builtin_amdgcn_readfirstlane(tid >> 6), lane = tid & 63, r32 = lane & 31, hi = lane >> 5;
    constexpr int DGS = 1032;
    bf16_t* dgs = (bf16_t*)lds;
    const int t0 = blk * 32, b = t0 / SEQ, p0 = t0 % SEQ;
    {
        const int ch = 2 * tid, g = wid >> 1;
        const bf16_t* base = U + (size_t)b * SEQ * AW + ch;
        unsigned raw[47];
#pragma unroll
        for (int j = 0; j < 47; ++j) { const int p = p0 - 8 + j, pc = min(max(p, 0), SEQ - 1); raw[j] = *(const unsigned*)(base + (size_t)pc * AW); }
#pragma unroll
        for (int j = 0; j < 47; ++j) { const int p = p0 - 8 + j; if (p < 0 || p >= SEQ) raw[j] = 0u; }
        if (g == 0) pool_dg<1>(raw, dgs + ch, p0); else if (g == 1) pool_dg<2>(raw, dgs + ch, p0); else if (g == 2) pool_dg<4>(raw, dgs + ch, p0); else pool_dg<8>(raw, dgs + ch, p0);
    }
    __syncthreads();
    {
        const int g = wid >> 1, nbase = (wid & 1) * 128;
        f32x16 acc[4];
#pragma unroll
        for (int nb = 0; nb < 4; ++nb) acc[nb] = f32x16{};
        const bf16_t* wp = WPT + ((size_t)(g * 256 + nbase + r32) * 256 + hi * 8);
        const bf16_t* ap = dgs + r32 * DGS + g * 256 + hi * 8;
#pragma unroll 4
        for (int ks = 0; ks < 16; ++ks) {
            const bf16x8 a = *reinterpret_cast<const bf16x8*>(ap + ks * 16);
#pragma unroll
            for (int nb = 0; nb < 4; ++nb) {
                const bf16x8 bb = *reinterpret_cast<const bf16x8*>(wp + (size_t)nb * 32 * 256 + ks * 16);
                acc[nb] = __builtin_amdgcn_mfma_f32_32x32x16_bf16(a, bb, acc[nb], 0, 0, 0);
            }
        }
        bf16_t* stg = (bf16_t*)(lds + 66048);
#pragma unroll
        for (int nb = 0; nb < 4; ++nb) {
            const int dg = g * 256 + nbase + nb * 32 + r32;
            const float ps = pscale[dg];
#pragma unroll
            for (int r = 0; r < 16; ++r) { const float y = acc[nb][r] * ps; stg[att::crow(r, hi) * 1024 + dg] = (bf16_t)(cvtpk(y, y) & 0xffffu); }
        }
    }
    __syncthreads();
    {
        const bf16_t* stg = (const bf16_t*)(lds + 66048);
#pragma unroll
        for (int i = 0; i < 8; ++i) {
            const int idx = i * 512 + tid, row = idx >> 7, ch = idx & 127;
            const u32x4 y = *(const u32x4*)(stg + row * 1024 + ch * 8);
            const size_t tok = (size_t)t0 + row;
            const u32x4 gq = __builtin_nontemporal_load((const u32x4*)(GP + tok * AW + ch * 8));
            u32x4 w;
            w.x = cvtpk(bf_lo(y.x) * bf_lo(gq.x), bf_hi(y.x) * bf_hi(gq.x)); w.y = cvtpk(bf_lo(y.y) * bf_lo(gq.y), bf_hi(y.y) * bf_hi(gq.y));
            w.z = cvtpk(bf_lo(y.z) * bf_lo(gq.z), bf_hi(y.z) * bf_hi(gq.z)); w.w = cvtpk(bf_lo(y.w) * bf_lo(gq.w), bf_hi(y.w) * bf_hi(gq.w));
            *(u32x4*)(MIX + tok * LDP + AW + ch * 8) = w;
        }
    }
    __syncthreads();
}

#define XB_TMO      128
#define XB_XCNT(j)  (256  + 64 * (j))
#define XB_XSUB(j)  (1280 + 64 * (j))
#define XB_XGEN(j)  (2304 + 64 * (j))
#define XB_TOP      3328
#define XB_TOPGEN   3392
#define XCD_BAR_WORDS 3456
#define XB_SPIN_CAP (1u << 18)

__device__ __forceinline__ unsigned xb_ld(unsigned* p)              { return __hip_atomic_load(p, __ATOMIC_RELAXED, __HIP_MEMORY_SCOPE_AGENT); }
__device__ __forceinline__ unsigned xb_add(unsigned* p, unsigned v) { return __hip_atomic_fetch_add(p, v, __ATOMIC_RELAXED, __HIP_MEMORY_SCOPE_AGENT); }
__device__ __forceinline__ unsigned xb_xcc_id() { return (unsigned)__builtin_amdgcn_s_getreg((3 << 11) | 20) & 0xFu; }
#define XB_SPIN(cond, bar) do { unsigned _sp = 0; while (cond) { __builtin_amdgcn_s_sleep(1); \
    if ((++_sp & 255u) == 0u) { if (xb_ld(&(bar)[XB_TMO])) break; if (_sp > XB_SPIN_CAP) { atomicAdd(&(bar)[XB_TMO], 1u); break; } } } } while (0)

struct XcdBarrier {
    unsigned* bar; unsigned x;
    volatile LAS unsigned* st;
};

__device__ __forceinline__ XcdBarrier xcd_barrier_post(unsigned* bar, volatile LAS unsigned* st) {
    XcdBarrier b; b.bar = bar; b.x = xb_xcc_id(); b.st = st;
    if (threadIdx.x == 0) (void)xb_add(&bar[XB_XCNT(b.x)], 1u);
    return b;
}
__device__ __forceinline__ void xcd_barrier_complete(unsigned* bar, unsigned x, unsigned& nloc, unsigned& nx) {
    const unsigned G = gridDim.x * gridDim.y * gridDim.z;
    unsigned sum, cnt, mine, sp = 0u;
    for (;;) {
        sum = 0u; cnt = 0u; mine = 0u;
#pragma unroll
        for (unsigned j = 0; j < 16; ++j) { const unsigned c = xb_ld(&bar[XB_XCNT(j)]); sum += c; cnt += (c > 0u) ? 1u : 0u; mine = (j == x) ? c : mine; }
        if (sum == G) break;
        __builtin_amdgcn_s_sleep(1);
        if ((++sp & 255u) == 0u) { if (xb_ld(&bar[XB_TMO])) break; if (sp > XB_SPIN_CAP) { atomicAdd(&bar[XB_TMO], 1u); break; } }
    }
    nloc = mine > 0u ? mine : 1u; nx = cnt > 0u ? cnt : 1u;
}

__device__ __forceinline__ void xcd_barrier(const XcdBarrier& b) {
    asm volatile("s_waitcnt vmcnt(0)" ::: "memory");
    __syncthreads();
    if (threadIdx.x == 0) {
        unsigned* bar = b.bar;
        __builtin_amdgcn_s_waitcnt(0);
        unsigned nloc = b.st[0], nx = b.st[1];
        if (nloc == 0u) { xcd_barrier_complete(bar, b.x, nloc, nx); b.st[0] = nloc; b.st[1] = nx; }
        const unsigned old = xb_add(&bar[XB_XSUB(b.x)], 1u);
        const unsigned gen = old / nloc;
        if (old + 1u == (gen + 1u) * nloc) {
            __builtin_amdgcn_fence(__ATOMIC_RELEASE, "agent");
            asm volatile("s_waitcnt vmcnt(0)" ::: "memory");
            const unsigned og = xb_add(&bar[XB_TOP], 1u);
            const unsigned tg = og / nx;
            if (og + 1u == (tg + 1u) * nx) xb_add(&bar[XB_TOPGEN], 1u);
            else XB_SPIN(xb_ld(&bar[XB_TOPGEN]) == tg, bar);
            __builtin_amdgcn_fence(__ATOMIC_ACQUIRE, "agent");
            xb_add(&bar[XB_XGEN(b.x)], 1u);
            asm volatile("s_waitcnt vmcnt(0)" ::: "memory");
        } else {
            XB_SPIN(xb_ld(&bar[XB_XGEN(b.x)]) == gen, bar);
            __builtin_amdgcn_fence(__ATOMIC_ACQUIRE, "agent");
            asm volatile("s_waitcnt vmcnt(0)" ::: "memory");
        }
    }
    __syncthreads();
}

struct TItem { const float* W; bf16_t* WT; const float* kscale; int K, N, k0, n0, drow, ldw; };
__device__ __forceinline__ void titem_load(const TItem& t, float (&tv)[32], int lane) {
#pragma unroll
    for (int i = 0; i < 32; ++i) tv[i] = __builtin_nontemporal_load(t.W + (size_t)(t.k0 + 2 * i + (lane >> 5)) * t.N + t.n0 + (lane & 31));
}
__device__ __forceinline__ void titem_finish(const TItem& t, float (&tv)[32], LAS float* scr, int lane) {
    if (t.kscale) {
#pragma unroll
        for (int i = 0; i < 32; ++i) tv[i] *= t.kscale[t.k0 + 2 * i + (lane >> 5)];
    }
#pragma unroll
    for (int i = 0; i < 32; ++i) scr[(2 * i + (lane >> 5)) * 33 + (lane & 31)] = tv[i];
    asm volatile("s_waitcnt lgkmcnt(0)" ::: "memory");
    const int c = lane & 7;
#pragma unroll
    for (int j = 0; j < 4; ++j) { const int n = (lane >> 3) + 8 * j; const LAS float* s = scr + (8 * c) * 33 + n;
        u32x4 o; o.x = cvtpk(s[0 * 33], s[1 * 33]); o.y = cvtpk(s[2 * 33], s[3 * 33]); o.z = cvtpk(s[4 * 33], s[5 * 33]); o.w = cvtpk(s[6 * 33], s[7 * 33]);
        *(u32x4*)(t.WT + (size_t)(t.drow + n) * t.ldw + t.k0 + 8 * c) = o; }
    asm volatile("s_waitcnt lgkmcnt(0)" ::: "memory");
}

struct Args {
    const float* in[13]; float* out; unsigned char* ws;
    double turns[8];
    int ph_lo, ph_hi;
};

__global__ void __launch_bounds__(512, 2) mega_fwd(Args args) {
    extern __shared__ __attribute__((aligned(16))) unsigned char lds[];
    const int tid = threadIdx.x, lane = tid & 63, wave = __builtin_amdgcn_readfirstlane(tid >> 6);
    const int G = gridDim.x, bx = blockIdx.x;
    const int vcu = (G % 8 == 0) ? (bx % 8) * (G / 8) + bx / 8 : bx;
    unsigned char* ws = args.ws;
    const float* x = args.in[0]; const float* norm_w = args.in[1]; const float* w_in = args.in[2]; const float* qnw = args.in[3]; const float* knw = args.in[4];
    const float* lq1 = args.in[5]; const float* lk1 = args.in[6]; const float* lq2 = args.in[7]; const float* lk2 = args.in[8];
    const float* subw = args.in[9]; const float* w_pool = args.in[10]; const float* pscale = args.in[11]; const float* w_out = args.in[12];
    float* ROPE = (float*)(ws + WS_ROPE);
    bf16_t* WPT = (bf16_t*)(ws + WS_WPT); bf16_t* WIT = (bf16_t*)(ws + WS_WIT); bf16_t* WOT = (bf16_t*)(ws + WS_WOT); bf16_t* XS = (bf16_t*)(ws + WS_XS);
    bf16_t* QB = (bf16_t*)(ws + WS_Q); bf16_t* KB = (bf16_t*)(ws + WS_K); bf16_t* VB = (bf16_t*)(ws + WS_V);
    bf16_t* GA = (bf16_t*)(ws + WS_GA); bf16_t* UB = (bf16_t*)(ws + WS_U); bf16_t* GP = (bf16_t*)(ws + WS_GP); bf16_t* MIX = (bf16_t*)(ws + WS_MIX);
    const int lo = args.ph_lo, hi = args.ph_hi;
    volatile LAS unsigned* MISC = (volatile LAS unsigned*)((LAS unsigned char*)lds + 133120);
    if (tid < 2) MISC[tid] = 0u;
    __syncthreads();
    XcdBarrier bar = xcd_barrier_post((unsigned*)(ws + WS_CTL), MISC);
#ifdef ONLY_PHASE
#define IN(k) ((k) == ONLY_PHASE && lo <= (k) && (k) < hi)
#else
#define IN(k) (lo <= (k) && (k) < hi)
#endif
#define SEAM(k) do { if (IN(k) && IN((k) + 1)) { if ((k) == 0) cg::this_grid().sync(); else xcd_barrier(bar); } } while (0)

    if (IN(0)) {
        LAS float* scr = (LAS float*)((LAS unsigned char*)lds + wave * 16384);
        const int gw = vcu * 8 + wave, NGW = G * 8;
        constexpr int I_IN = (DM / 64) * (NIN / 32), I_OUT = (DM / 64) * (DM / 32), I_P = 4 * (256 / 64) * (256 / 32);
        auto decode = [&](int it) -> TItem {
            TItem t; int r = it;
            if (r < I_IN) { const int nblk = NIN / 32, kb = r / nblk, nb = r % nblk, n0 = nb * 32, a = n0 & 255;
                t.W = w_in; t.WT = WIT; t.kscale = norm_w; t.K = DM; t.ldw = LDP; t.N = NIN; t.k0 = kb * 64; t.n0 = n0; t.drow = (n0 & ~255) + ((a >> 5) & 1) * 128 + (a >> 6) * 32; return t; }
            r -= I_IN;
            if (r < I_OUT) { const int nblk = DM / 32, kb = r / nblk, nb = r % nblk;
                t.W = w_out; t.WT = WOT; t.kscale = nullptr; t.K = DM; t.ldw = LDP; t.N = DM; t.k0 = kb * 64; t.n0 = nb * 32; t.drow = nb * 32; return t; }
            r -= I_OUT;
            { const int g = r / 32, rr = r % 32, kb = rr / 8, nb = rr % 8;
              t.W = w_pool + (size_t)g * 65536; t.WT = WPT + (size_t)g * 65536; t.kscale = nullptr; t.K = 256; t.ldw = 256; t.N = 256; t.k0 = kb * 64; t.n0 = nb * 32; t.drow = nb * 32; return t; }
        };
        constexpr int NIT = I_IN + I_OUT + I_P;
        for (int it = gw; it < NIT; it += 2 * NGW) {
            const int it1 = it + NGW; const bool two = it1 < NIT;
            const TItem ta = decode(it), tb = decode(two ? it1 : it);
            float va[32], vb[32];
            titem_load(ta, va, lane);
            if (two) titem_load(tb, vb, lane);
            titem_finish(ta, va, scr, lane);
            if (two) titem_finish(tb, vb, scr, lane);
        }
        for (int m = gw; m < MTOK; m += 2 * NGW) {
            const int m2 = (m + NGW < MTOK) ? m + NGW : m;
            const f32x4* xr0 = (const f32x4*)(x + (size_t)m * DM) + lane; const f32x4* xr1 = (const f32x4*)(x + (size_t)m2 * DM) + lane;
            f32x4 v[8], w2[8]; float s0 = 0.f, s1 = 0.f;
#pragma unroll
            for (int j = 0; j < 8; ++j) { v[j] = __builtin_nontemporal_load(xr0 + 64 * j); w2[j] = __builtin_nontemporal_load(xr1 + 64 * j); }
#pragma unroll
            for (int j = 0; j < 8; ++j) { s0 += (v[j].x * v[j].x + v[j].y * v[j].y) + (v[j].z * v[j].z + v[j].w * v[j].w); s1 += (w2[j].x * w2[j].x + w2[j].y * w2[j].y) + (w2[j].z * w2[j].z + w2[j].w * w2[j].w); }
            const float r0 = 1.0f / sqrtf(wave_sum(s0) * (1.0f / DM) + EPSN), r1 = 1.0f / sqrtf(wave_sum(s1) * (1.0f / DM) + EPSN);
            u32x2* o0 = (u32x2*)(XS + (size_t)m * LDP) + lane; u32x2* o1 = (u32x2*)(XS + (size_t)m2 * LDP) + lane;
#pragma unroll
            for (int j = 0; j < 8; ++j) { u32x2 w; w.x = cvtpk(v[j].x * r0, v[j].y * r0); w.y = cvtpk(v[j].z * r0, v[j].w * r0); o0[64 * j] = w;
                                          u32x2 y; y.x = cvtpk(w2[j].x * r1, w2[j].y * r1); y.y = cvtpk(w2[j].z * r1, w2[j].w * r1); o1[64 * j] = y; }
        }
        for (int e = (vcu * 512 + tid); e < SEQ * 8; e += G * 512) {
            const int pos = e >> 3, i = e & 7;
            const double t = (double)pos * args.turns[i];
            const float fr = (float)(t - floor(t));
            ROPE[pos * 16 + i] = __builtin_amdgcn_cosf(fr);
            ROPE[pos * 16 + 8 + i] = __builtin_amdgcn_sinf(fr);
        }
    }
    SEAM(0);

    if (IN(1)) {
        pg8::Gemm g{XS, WIT, MTOK, NIN, DM, LDP}; pg8::StaticOrder S; S.init(MTOK, NIN, G, bx);
        EpiProj E{QB, KB, VB, GA, UB, GP, qnw, knw, ROPE, 0.125f * LOG2E};
        pg8::gemm_phase<EpiProj, pg8::StaticOrder, true, true>((LAS unsigned char*)lds, g, S, E);
    }
    SEAM(1);

    if (IN(2)) {
        const float d1 = wave_sum(lq1[lane] * lk1[lane]), d2 = wave_sum(lq2[lane] * lk2[lane]);
        const float lam = __expf(d1) - __expf(d2) + LAM_INIT;
        const float mq = wave_max(fabsf(qnw[lane])), mk = wave_max(fabsf(knw[lane]));
        const float M2 = 8.0f * mq * mk * LOG2E * 1.02f;
        const float lam_s = __uint_as_float(__builtin_amdgcn_readfirstlane(__float_as_uint(lam)));
        const float nm2_s = __uint_as_float(__builtin_amdgcn_readfirstlane(__float_as_uint(-M2)));
        att::Tensors T{QB, KB, VB, GA, MIX, subw, lam_s, nm2_s};
        for (int u = vcu; u < 256; u += G) { const int bh = u >> 4, qb = u & 15;
            if (nm2_s < -40.0f) att2::unit<true>(bh >> 3, bh & 7, qb, T, (char*)lds); else att2::unit<false>(bh >> 3, bh & 7, qb, T, (char*)lds); }
        for (int blk = vcu; blk < MTOK / 32; blk += G) pool_job(blk, UB, GP, WPT, pscale, MIX, (char*)lds);
    }
    SEAM(2);

    if (IN(3)) {
        pg8::Gemm g{MIX, WOT, MTOK, DM, DM, LDP}; pg8::StaticOrder S; S.init(MTOK, DM, G, bx);
        EpiOut E{x, args.out};
        pg8::gemm_phase<EpiOut, pg8::StaticOrder, true, true>((LAS unsigned char*)lds, g, S, E);
    }
#undef IN
#undef SEAM
}

constexpr int LDS_BYTES = 135168;
extern "C" void kernel_launch(void* const* d_in, const int* in_sizes, int n_in, void* d_out, int out_size, void* d_ws, size_t ws_size, hipStream_t stream) {
    static int grid = 0;
    if (grid == 0) {
        if (n_in != 13 || in_sizes[0] != MTOK * DM || out_size != MTOK * DM || ws_size < WS_END) { fprintf(stderr, "kernel_launch: unexpected shapes\n"); grid = -1; return; }
        int dev = 0, cus = 0, per_cu = 0;
        (void)hipGetDevice(&dev);
        (void)hipDeviceGetAttribute(&cus, hipDeviceAttributeMultiprocessorCount, dev);
        if (hipFuncSetAttribute((const void*)mega_fwd, hipFuncAttributeMaxDynamicSharedMemorySize, LDS_BYTES) != hipSuccess) { fprintf(stderr, "kernel_launch: hipFuncSetAttribute failed\n"); grid = -1; return; }
        if (hipOccupancyMaxActiveBlocksPerMultiprocessor(&per_cu, (const void*)mega_fwd, 512, LDS_BYTES) != hipSuccess || per_cu < 1) { fprintf(stderr, "kernel_launch: occupancy query failed (%d)\n", per_cu); per_cu = 1; }
        (void)hipGetLastError();
        grid = cus * (per_cu > 1 ? 1 : per_cu);
        if (grid > 256) grid = 256;
    }
    if (grid < 0) return;
    Args a{};
    for (int i = 0; i < 13; ++i) a.in[i] = (const float*)d_in[i];
    a.out = (float*)d_out; a.ws = (unsigned char*)d_ws;
    for (int i = 0; i < 8; ++i) a.turns[i] = std::pow(500000.0, -(double)(2 * i) / 16.0) / 6.283185307179586476925;
    constexpr int NL = MK_N_LAUNCHES;
    (void)hipMemsetAsync((char*)d_ws + WS_CTL, 0, CTL_BYTES, stream);
    if (NL == 1) {
        a.ph_lo = 0; a.ph_hi = 4;
        void* kargs[] = {&a};
        hipError_t e = hipLaunchCooperativeKernel((const void*)mega_fwd, dim3(grid), dim3(512), kargs, LDS_BYTES, stream);
        if (e != hipSuccess) fprintf(stderr, "cooperative launch failed: %s (grid %d)\n", hipGetErrorString(e), grid);
        if (PROBE_EXTRA_PHASE >= 0) { a.ph_lo = PROBE_EXTRA_PHASE; a.ph_hi = PROBE_EXTRA_PHASE + 1; hipLaunchKernelGGL(mega_fwd, dim3(grid), dim3(512), LDS_BYTES, stream, a); }
    } else {
        for (int p = 0; p < 4; ++p) { a.ph_lo = p; a.ph_hi = p + 1; hipLaunchKernelGGL(mega_fwd, dim3(grid), dim3(512), LDS_BYTES, stream, a); }
    }
}
```
